# Optimizing an MI355X kernel written in HIP

```python
import jax, jax.numpy as jnp
from jax import lax
import numpy as np

D_MODEL = 2048
BATCH = 8
SEQ = 2048
DEPTH = 1

EPS = 1e-6

POOL_WINDOWS = (2, 4, 8, 16)
POOL_GROUPS = len(POOL_WINDOWS)
POOL_WIDTH = D_MODEL // 2
POOL_GROUP_DIM = POOL_WIDTH // POOL_GROUPS
POOL_OUT_DIM = D_MODEL // POOL_GROUPS

HG_EXPAND = 128
HG_HEADS = D_MODEL // HG_EXPAND
HG_HEAD_V = D_MODEL // HG_HEADS
HG_KEY_WIDTH = HG_HEADS * HG_EXPAND
HG_VAL_WIDTH = HG_HEADS * HG_HEAD_V
HG_CHUNK = 64

IN_SPLIT_WIDTHS = (POOL_WIDTH, HG_KEY_WIDTH, HG_KEY_WIDTH, HG_VAL_WIDTH, HG_VAL_WIDTH, D_MODEL, D_MODEL)
IN_WIDTH = sum(IN_SPLIT_WIDTHS)

PEER_HEADS = 8
PEER_NKEYS = 128
PEER_EXPERTS = PEER_NKEYS * PEER_NKEYS
PEER_DKEY = 256
PEER_TOPK = 16
PEER_BLOCK = 128

kernel_name = "hybrid_pool_hgrn2_peer_adaln"


def rms_norm(x, gain):
    xf = x.astype(jnp.float32)
    y = xf * lax.rsqrt(jnp.mean(xf * xf, axis=-1, keepdims=True) + EPS)
    return (y * gain.astype(jnp.float32)).astype(x.dtype)


def modulate(h, shift, scale):
    return h * (1.0 + scale[:, None, :]) + shift[:, None, :]


def pool_mixer(p, pool_w, pool_scale):
    b, s, _ = p.shape
    pf = p.astype(jnp.float32)
    cs = jnp.cumsum(pf, axis=1)
    pos = jnp.arange(s)
    outs = []
    for g, w in enumerate(POOL_WINDOWS):
        lo, hi = g * POOL_GROUP_DIM, (g + 1) * POOL_GROUP_DIM
        csg = cs[..., lo:hi]
        prev = jnp.pad(csg, ((0, 0), (w, 0), (0, 0)))[:, :s]
        cnt = jnp.minimum(pos + 1, w).astype(jnp.float32)[None, :, None]
        outs.append((csg - prev) / cnt - pf[..., lo:hi])
    pooled = jnp.stack(outs, axis=2)
    y = jnp.einsum('bsgd,gde->bsge', pooled, pool_w.astype(jnp.float32))
    y = y.reshape(b, s, D_MODEL) * pool_scale.astype(jnp.float32)
    return y.astype(p.dtype)


def hgrn2_mixer(q, f_logit, i, g, lb, hg_norm):
    b, s, _ = q.shape
    n = s // HG_CHUNK
    lbf = lb.astype(jnp.float32)
    log_f = jnp.logaddexp(jnp.log(lbf), jnp.log1p(-lbf) + jax.nn.log_sigmoid(f_logit.astype(jnp.float32)))
    k = -jnp.expm1(log_f)

    def to_chunks(t, d):
        return t.astype(jnp.float32).reshape(b, n, HG_CHUNK, HG_HEADS, d).transpose(1, 0, 3, 2, 4)

    qc = to_chunks(q, HG_EXPAND)
    kc = to_chunks(k, HG_EXPAND)
    lfc = to_chunks(log_f, HG_EXPAND)
    ic = to_chunks(i, HG_HEAD_V)
    mask = jnp.tril(jnp.ones((HG_CHUNK, HG_CHUNK), dtype=bool))[:, :, None]

    def step(state, inp):
        qx, kx, lfx, ix = inp
        cum = jnp.cumsum(lfx, axis=2)
        diff = cum[:, :, :, None, :] - cum[:, :, None, :, :]
        decay = jnp.exp(jnp.where(mask, diff, -jnp.inf))
        attn = jnp.einsum('bhtk,bhsk,bhtsk->bhts', qx, kx, decay)
        o = jnp.einsum('bhts,bhsv->bhtv', attn, ix) + jnp.einsum('bhtk,bhkv->bhtv', qx * jnp.exp(cum), state)
        last = cum[:, :, -1:, :]
        new_state = jnp.exp(last[:, :, 0, :])[..., None] * state + jnp.einsum('bhsk,bhsv->bhkv', kx * jnp.exp(last - cum), ix)
        return new_state, o

    state0 = jnp.zeros((b, HG_HEADS, HG_EXPAND, HG_HEAD_V), jnp.float32)
    _, o = lax.scan(step, state0, (qc, kc, lfc, ic))
    o = o.transpose(1, 0, 3, 2, 4).reshape(b, s, HG_HEADS, HG_HEAD_V)
    o = o * lax.rsqrt(jnp.mean(o * o, axis=-1, keepdims=True) + EPS) * hg_norm.astype(jnp.float32)
    o = o.reshape(b, s, HG_VAL_WIDTH) * jax.nn.silu(g.astype(jnp.float32))
    return o.astype(q.dtype)


def peer_ffn(h, w_q, sub_keys, u, v):
    b, s, d = h.shape
    t = b * s
    hf = h.reshape(t, d)
    q = (hf @ w_q).astype(jnp.float32).reshape(t, PEER_HEADS, 2, PEER_DKEY // 2)
    scores = jnp.einsum('thpd,hpnd->thpn', q, sub_keys.astype(jnp.float32))
    vals, idx = lax.top_k(scores, PEER_TOPK)
    cand = (vals[:, :, 0, :, None] + vals[:, :, 1, None, :]).reshape(t, PEER_HEADS, PEER_TOPK * PEER_TOPK)
    cand_idx = (idx[:, :, 0, :, None] * PEER_NKEYS + idx[:, :, 1, None, :]).reshape(t, PEER_HEADS, PEER_TOPK * PEER_TOPK)
    top_s, sel = lax.top_k(cand, PEER_TOPK)
    experts = jnp.take_along_axis(cand_idx, sel, axis=-1)
    gates = jax.nn.softmax(top_s, axis=-1)
    nb = t // PEER_BLOCK
    xb = hf.reshape(nb, PEER_BLOCK, d)
    eb = experts.reshape(nb, PEER_BLOCK, PEER_HEADS * PEER_TOPK)
    gb = gates.reshape(nb, PEER_BLOCK, PEER_HEADS * PEER_TOPK)

    def block_fn(args):
        xk, ek, gk = args
        hid = jax.nn.gelu(jnp.einsum('td,ted->te', xk, u[ek]).astype(jnp.float32), approximate=False)
        return jnp.einsum('te,ted->td', (gk * hid).astype(v.dtype), v[ek])

    y = lax.map(block_fn, (xb, eb, gb))
    return y.reshape(b, s, d).astype(h.dtype)


def setup_inputs(seed: int = 0) -> dict:
    key = jax.random.key(seed)
    ks = jax.random.split(key, 20)
    f32 = jnp.float32
    nrm = lambda k, shape, sc: jax.random.normal(k, shape, f32) * sc
    return {
        "x": nrm(ks[0], (BATCH, SEQ, D_MODEL), 1.0),
        "c": nrm(ks[1], (BATCH, D_MODEL), 1.0),
        "w_ada": nrm(ks[2], (DEPTH, D_MODEL, 6 * D_MODEL), 0.1 * D_MODEL ** -0.5),
        "b_ada": nrm(ks[3], (DEPTH, 6 * D_MODEL), 0.01),
        "norm1": 1.0 + nrm(ks[4], (DEPTH, D_MODEL), 0.02),
        "w_in": nrm(ks[5], (DEPTH, D_MODEL, IN_WIDTH), D_MODEL ** -0.5),
        "pool_w": nrm(ks[6], (DEPTH, POOL_GROUPS, POOL_GROUP_DIM, POOL_OUT_DIM), POOL_GROUP_DIM ** -0.5),
        "pool_scale": 1.0 + nrm(ks[7], (DEPTH, D_MODEL), 0.02),
        "lb_logits": nrm(ks[8], (DEPTH + 1, HG_KEY_WIDTH), 0.5),
        "hg_norm": 1.0 + nrm(ks[9], (DEPTH, HG_HEADS, HG_HEAD_V), 0.02),
        "w_out": nrm(ks[10], (DEPTH, D_MODEL, D_MODEL), D_MODEL ** -0.5),
        "norm2": 1.0 + nrm(ks[11], (DEPTH, D_MODEL), 0.02),
        "peer_wq": nrm(ks[12], (DEPTH, D_MODEL, PEER_HEADS * PEER_DKEY), D_MODEL ** -0.5),
        "peer_keys": nrm(ks[13], (DEPTH, PEER_HEADS, 2, PEER_NKEYS, PEER_DKEY // 2), (PEER_DKEY // 2) ** -0.5),
        "peer_u": nrm(ks[14], (DEPTH, PEER_EXPERTS, D_MODEL), D_MODEL ** -0.5),
        "peer_v": nrm(ks[15], (DEPTH, PEER_EXPERTS, D_MODEL), PEER_HEADS ** -0.5),
        "final_norm": 1.0 + nrm(ks[16], (D_MODEL,), 0.02),
    }


def reference(x, c, w_ada, b_ada, norm1, w_in, pool_w, pool_scale, lb_logits, hg_norm, w_out,
              norm2, peer_wq, peer_keys, peer_u, peer_v, final_norm):
    lb_all = jnp.cumsum(jax.nn.softmax(lb_logits.astype(jnp.float32), axis=0), axis=0)
    split_at = [int(v) for v in np.cumsum(IN_SPLIT_WIDTHS)[:-1]]
    cs = jax.nn.silu(c)
    for l in range(DEPTH):
        ada = cs @ w_ada[l] + b_ada[l]
        shift1, scale1, gate1, shift2, scale2, gate2 = jnp.split(ada, 6, axis=-1)
        h = modulate(rms_norm(x, norm1[l]), shift1, scale1)
        proj = h @ w_in[l]
        p_pool, p_q, p_f, p_i, p_g, g_a, g_b = jnp.split(proj, split_at, axis=-1)
        y_a = pool_mixer(p_pool, pool_w[l], pool_scale[l])
        y_b = hgrn2_mixer(p_q, p_f, p_i, p_g, lb_all[l], hg_norm[l])
        merged = jax.nn.sigmoid(g_a) * y_a + jax.nn.sigmoid(g_b) * y_b
        x = x + (1.0 + gate1)[:, None, :] * (merged @ w_out[l])
        h2 = modulate(rms_norm(x, norm2[l]), shift2, scale2)
        x = x + (1.0 + gate2)[:, None, :] * peer_ffn(h2, peer_wq[l], peer_keys[l], peer_u[l], peer_v[l])
    return rms_norm(x, final_norm)
```

```cpp
#include <hip/hip_runtime.h>
#include <cstdio>
#include <cstdint>

#ifndef MK_N_LAUNCHES
#define MK_N_LAUNCHES 11
#endif

namespace pg8 {
#define PG8_LAS __attribute__((address_space(3)))
typedef unsigned short bf16_t;
typedef short bf16x8 __attribute__((ext_vector_type(8)));
typedef float f32x4 __attribute__((ext_vector_type(4)));
typedef unsigned u32x4 __attribute__((ext_vector_type(4)));
constexpr int BM = 256, BK = 64, HALF = 128, HTB = HALF * BK * 2  , STAGE_BYTES = 8 * HTB, NXCD = 8, WGM = 8;

__host__ __device__ __forceinline__ int lds_byte(int r, int c) { const int st = (r >> 4) * 2 + (c >> 5), rr = r & 15, cc = c & 31, ob = rr * 64 + cc * 2; return st * 1024 + (ob ^ (((ob >> 9) & 1) << 5)); }
__host__ __device__ __forceinline__ void stage_rc(int b, int& R, int& C) { const int st = b / 1024, sb = b % 1024, swz = sb ^ (((sb >> 9) & 1) << 5); R = (st >> 1) * 16 + swz / 64; C = (st & 1) * 32 + (swz % 64) / 2; }
__host__ __device__ __forceinline__ int perm32(int rho) { const int n = rho >> 4, i = rho & 15; return 8 * (i >> 2) + 4 * n + (i & 3); }

struct Unit { int pm, pn; };
struct Gemm { const bf16_t* A; const bf16_t* Bt; int M, N, K, lda, ldb, a_gshift, a_gstride; };

struct StaticOrder {
    int nM, nN, nwg, G, c;
    __host__ __device__ void init(int M, int N, int G_, int c_) { nM = M / BM; nN = N / BM; nwg = nM * nN; G = G_; c = c_; }
    __host__ __device__ bool next(int i, Unit& u) const {
        const long L = (long)i * G + c; if (L >= nwg) return false;
        int wgid = (int)L; { const int q = nwg / NXCD, r = nwg % NXCD, xcd = wgid % NXCD, off = wgid / NXCD; wgid = (xcd < r ? xcd * (q + 1) : r * (q + 1) + (xcd - r) * q) + off; }
        const int nig = WGM * nN, gid = wgid / nig, fm = gid * WGM, gsz = (nM - fm) < WGM ? (nM - fm) : WGM;
        u.pm = fm + ((wgid % nig) % gsz); u.pn = (wgid % nig) / gsz; return true;
    }
};

__device__ __forceinline__ unsigned cvt_pk_bf16(float lo, float hi) { unsigned r; asm volatile("v_cvt_pk_bf16_f32 %0, %1, %2" : "=v"(r) : "v"(lo), "v"(hi)); return r; }

template <class Epi, bool ALIGN_EPI>
__device__ __forceinline__ void gemm_phase(PG8_LAS unsigned char* lds, const Gemm g, const StaticOrder& S, const Epi& E) {
    const int tid = threadIdx.x, wid = __builtin_amdgcn_readfirstlane(tid >> 6), lane = tid & 63, wr = wid >> 2, wc = wid & 3, fr = lane & 15, fq = lane >> 4;
    const int K = g.K, nt = K / BK;
    unsigned voffA[2], voffB[2];
#pragma unroll
    for (int i = 0; i < 2; ++i) { int R, C; stage_rc(tid * 16 + i * 8192, R, C); const int Rb = Epi::PERM ? ((R & ~31) + perm32(R & 31)) : R;
        voffA[i] = (unsigned)(R * g.lda + C) * 2u; voffB[i] = (unsigned)(Rb * g.ldb + C) * 2u; }
    const size_t kstep = (size_t)(BK * 2);
    const size_t hstepA = (size_t)HALF * g.lda * 2, hstepB = (size_t)HALF * g.ldb * 2;
    const size_t tstepA = 2 * hstepA, tstepB = 2 * hstepB;
    const unsigned ldsw = (unsigned)wid * 1024u;
    const int aoff = lds_byte(wr * 64 + fr, fq * 8), boff = lds_byte(wc * 32 + fr, fq * 8);
#define PG8_SA(b, h) (((b) * 2 + (h)) * HTB)
#define PG8_SB(b, h) ((4 + (b) * 2 + (h)) * HTB)
#define PG8_STAGE(bufoff, gbase, voff) do { _Pragma("unroll") for (int _i = 0; _i < 2; ++_i) \
        __builtin_amdgcn_global_load_lds((const unsigned*)((const char*)(gbase) + (voff)[_i]), (PG8_LAS unsigned*)(lds + (bufoff) + ldsw + _i * 8192), 16, 0, 0); } while (0)
#define PG8_LDA(dst, b, h) do { _Pragma("unroll") for (int m = 0; m < 4; ++m) _Pragma("unroll") for (int k = 0; k < 2; ++k) dst[m][k] = *(const PG8_LAS bf16x8*)(lds + PG8_SA(b, h) + aoff + m * 2048 + k * 1024); } while (0)
#define PG8_LDB(dst, b, h) do { _Pragma("unroll") for (int n = 0; n < 2; ++n) _Pragma("unroll") for (int k = 0; k < 2; ++k) dst[n][k] = *(const PG8_LAS bf16x8*)(lds + PG8_SB(b, h) + boff + n * 2048 + k * 1024); } while (0)
#define PG8_MMA(ai, bj, At, Bt) do { __builtin_amdgcn_s_setprio(1); _Pragma("unroll") for (int m = 0; m < 4; ++m) _Pragma("unroll") for (int n = 0; n < 2; ++n) _Pragma("unroll") for (int k = 0; k < 2; ++k) \
        acc[ai][bj][m][n] = __builtin_amdgcn_mfma_f32_16x16x32_bf16(Bt[n][k], At[m][k], acc[ai][bj][m][n], 0, 0, 0); __builtin_amdgcn_s_setprio(0); } while (0)
#define PG8_WAIT_V(n) asm volatile("s_waitcnt vmcnt(" #n ")" ::: "memory")
#define PG8_WAIT_L(n) asm volatile("s_waitcnt lgkmcnt(" #n ")" ::: "memory")
#define PG8_BAR __builtin_amdgcn_s_barrier()
#define PG8_SCHED __builtin_amdgcn_sched_barrier(0)
#define PG8_UA(u) ((const char*)g.A + (size_t)(u).pm * tstepA + (size_t)(((u).pn >> g.a_gshift) * g.a_gstride) * 2)
#define PG8_UB(u) ((const char*)g.Bt + (size_t)(u).pn * tstepB)
    Unit cur, nxt; int ui = 0;
    if (!S.next(0, cur)) return;
    f32x4 acc[2][2][4][2];
#pragma unroll
    for (int a = 0; a < 2; ++a)
#pragma unroll
        for (int b = 0; b < 2; ++b)
#pragma unroll
            for (int m = 0; m < 4; ++m)
#pragma unroll
                for (int n = 0; n < 2; ++n) acc[a][b][m][n] = (f32x4){0.f, 0.f, 0.f, 0.f};
    bf16x8 At[4][2], B0[2][2], B1[2][2];
    const char* cA = PG8_UA(cur); const char* cB = PG8_UB(cur);
    PG8_STAGE(PG8_SB(0, 0), cB, voffB); PG8_STAGE(PG8_SB(0, 1), cB + hstepB, voffB); PG8_STAGE(PG8_SA(0, 0), cA, voffA); PG8_STAGE(PG8_SA(0, 1), cA + hstepA, voffA);
    if (wr == 1) PG8_BAR;
    PG8_WAIT_V(2); PG8_BAR;
    PG8_STAGE(PG8_SB(1, 0), cB + kstep, voffB); PG8_STAGE(PG8_SA(1, 0), cA + kstep, voffA); PG8_STAGE(PG8_SB(1, 1), cB + hstepB + kstep, voffB);
    PG8_WAIT_V(6); PG8_BAR;
    for (;;) {
        const bool has_next = S.next(ui + 1, nxt);
        const char* nA = has_next ? PG8_UA(nxt) : cA; const char* nB = has_next ? PG8_UB(nxt) : cB;
        for (int t = 0; t < nt; t += 2) {
            const bool last = (t == nt - 2);
            const char* a1 = cA + (size_t)(t + 1) * kstep;
            const char* a2 = last ? nA : cA + (size_t)(t + 2) * kstep; const char* b2 = last ? nB : cB + (size_t)(t + 2) * kstep;
            const char* a3 = a2 + kstep; const char* b3 = b2 + kstep;
            PG8_LDB(B0, 0, 0); PG8_LDB(B1, 0, 1); PG8_SCHED; PG8_LDA(At, 0, 0); PG8_STAGE(PG8_SA(1, 1), a1 + hstepA, voffA);
            PG8_WAIT_V(8); PG8_WAIT_L(0); PG8_BAR; PG8_MMA(0, 0, At, B0); PG8_MMA(0, 1, At, B1); PG8_BAR; PG8_SCHED;
            PG8_LDA(At, 0, 1); PG8_STAGE(PG8_SB(0, 0), b2, voffB); PG8_STAGE(PG8_SB(0, 1), b2 + hstepB, voffB); PG8_STAGE(PG8_SA(0, 0), a2, voffA);
            PG8_WAIT_V(8); PG8_WAIT_L(0); PG8_BAR; PG8_MMA(1, 0, At, B0); PG8_MMA(1, 1, At, B1); PG8_BAR; PG8_SCHED;
            PG8_LDB(B0, 1, 0); PG8_LDB(B1, 1, 1); PG8_SCHED; PG8_LDA(At, 1, 0); PG8_STAGE(PG8_SA(0, 1), a2 + hstepA, voffA);
            PG8_WAIT_V(8); PG8_WAIT_L(0); PG8_BAR; PG8_MMA(0, 0, At, B0); PG8_MMA(0, 1, At, B1); PG8_BAR; PG8_SCHED;
            PG8_LDA(At, 1, 1); PG8_STAGE(PG8_SB(1, 0), b3, voffB); PG8_STAGE(PG8_SB(1, 1), b3 + hstepB, voffB); PG8_STAGE(PG8_SA(1, 0), a3, voffA);
            PG8_WAIT_V(8); PG8_WAIT_L(0); PG8_BAR; PG8_MMA(1, 0, At, B0); PG8_MMA(1, 1, At, B1); PG8_BAR; PG8_SCHED;
        }
        if constexpr (ALIGN_EPI) { if (wr == 0) PG8_BAR; }
        E(acc, cur, wr, wc, fr, fq);
        if (!has_next) break;
#pragma unroll
        for (int a = 0; a < 2; ++a)
#pragma unroll
            for (int b = 0; b < 2; ++b)
#pragma unroll
                for (int m = 0; m < 4; ++m)
#pragma unroll
                    for (int n = 0; n < 2; ++n) acc[a][b][m][n] = (f32x4){0.f, 0.f, 0.f, 0.f};
        cur = nxt; cA = nA; cB = nB; ++ui;
        if constexpr (ALIGN_EPI) { if (wr == 1) PG8_BAR; }
    }
    PG8_WAIT_V(0);
    if constexpr (!ALIGN_EPI) { if (wr == 0) PG8_BAR; }
    PG8_BAR;
#undef PG8_SA
#undef PG8_SB
#undef PG8_STAGE
#undef PG8_LDA
#undef PG8_LDB
#undef PG8_MMA
#undef PG8_WAIT_V
#undef PG8_WAIT_L
#undef PG8_BAR
#undef PG8_SCHED
#undef PG8_UA
#undef PG8_UB
}
}

constexpr int NWAVES = 8, NTHR = 512;
constexpr int T = 16384, DM = 2048, SEQ = 2048, NBATCH = 8, NIN = 13312, NADA = 12288;
constexpr int N_PHASES = 11;
constexpr int N_LAUNCHES = MK_N_LAUNCHES;
constexpr float EPS = 1e-6f;

constexpr size_t MiB = 1u << 20;
constexpr size_t WS_CTL = 0, CTL_ZERO_BYTES = 1 * MiB;
constexpr size_t WS_ADA = 512 * 1024;
constexpr size_t WS_WOUT = 1 * MiB, WS_WQ = 9 * MiB, WS_POOLW = 17 * MiB, WS_KEYS = 18 * MiB, WS_LB = 19 * MiB;
constexpr size_t WS_WIN = 20 * MiB, WS_H1 = 72 * MiB, WS_P = 136 * MiB, WS_GA = 168 * MiB, WS_Q = 232 * MiB, WS_LF = 296 * MiB, WS_I = 360 * MiB, WS_GG = 424 * MiB;
constexpr size_t WS_U = 488 * MiB, WS_V = 552 * MiB, WS_END = 616 * MiB;
constexpr size_t WS_POOLED = 20 * MiB, WS_YA = 72 * MiB, WS_MERGED = 136 * MiB, WS_H2 = 232 * MiB, WS_QP = 296 * MiB, WS_EIDX = 360 * MiB, WS_GATE = 368 * MiB;
constexpr int CW_BAR = 4096;

constexpr int RING_BYTES = 131072;
constexpr int LDSCTL_OFF = RING_BYTES, MISC_OFF = LDSCTL_OFF + 320;
constexpr int LDS_BYTES = 147456;

#define GAS __attribute__((address_space(1)))
#define LAS __attribute__((address_space(3)))
typedef unsigned short bf16;
typedef unsigned v4u __attribute__((ext_vector_type(4)));
typedef unsigned v2u __attribute__((ext_vector_type(2)));
typedef float f32x4 __attribute__((ext_vector_type(4)));
typedef GAS unsigned gu32;
#define RLX_AGENT __ATOMIC_RELAXED, __HIP_MEMORY_SCOPE_AGENT
#define LDS_WAIT() asm volatile("s_waitcnt lgkmcnt(0)" ::: "memory")
__device__ __forceinline__ unsigned f2bf(float f) { unsigned u = __builtin_bit_cast(unsigned, f); return (u + 0x7fffu + ((u >> 16) & 1u)) >> 16; }
__device__ __forceinline__ unsigned pk2(float lo, float hi) { return pg8::cvt_pk_bf16(lo, hi); }
__device__ __forceinline__ float bflo(unsigned w) { return __builtin_bit_cast(float, w << 16); }
__device__ __forceinline__ float bfhi(unsigned w) { return __builtin_bit_cast(float, w & 0xffff0000u); }
__device__ __forceinline__ float bf2f(bf16 b) { return __builtin_bit_cast(float, ((unsigned)b) << 16); }
__device__ __forceinline__ unsigned pkh2(float a, float b) { const _Float16 ha = (_Float16)a, hb = (_Float16)b; return (unsigned)__builtin_bit_cast(unsigned short, ha) | ((unsigned)__builtin_bit_cast(unsigned short, hb) << 16); }
__device__ __forceinline__ float h2f(unsigned short h) { return (float)__builtin_bit_cast(_Float16, h); }
__device__ __forceinline__ float sigmoidf_(float z) { return 1.0f / (1.0f + __expf(-z)); }
__device__ __forceinline__ float wave_sum(float v) {
#pragma unroll
    for (int o = 1; o < 64; o <<= 1) v += __shfl_xor(v, o);
    return v;
}

#define XB_TMO      128
#define XB_XCNT(j)  (256  + 64 * (j))
#define XB_XSUB(j)  (1280 + 64 * (j))
#define XB_XGEN(j)  (2304 + 64 * (j))
#define XB_TOP      3328
#define XB_TOPGEN   3392
#define XCD_BAR_WORDS 3456
#define XB_SPIN_CAP (1u << 18)
__device__ __forceinline__ unsigned xb_ld(unsigned* p)              { return __hip_atomic_load(p, __ATOMIC_RELAXED, __HIP_MEMORY_SCOPE_AGENT); }
__device__ __forceinline__ unsigned xb_add(unsigned* p, unsigned v) { return __hip_atomic_fetch_add(p, v, __ATOMIC_RELAXED, __HIP_MEMORY_SCOPE_AGENT); }
__device__ __forceinline__ unsigned xb_xcc_id() { return (unsigned)__builtin_amdgcn_s_getreg((3 << 11) | 20) & 0xFu; }
#define XB_SPIN(cond, bar) do { unsigned _sp = 0; while (cond) { __builtin_amdgcn_s_sleep(1); \
    if ((++_sp & 255u) == 0u) { if (xb_ld(&(bar)[XB_TMO])) break; if (_sp > XB_SPIN_CAP) { atomicAdd(&(bar)[XB_TMO], 1u); break; } } } } while (0)
struct XcdBarrier { unsigned* bar; unsigned x; volatile LAS unsigned* st; };
__device__ __forceinline__ XcdBarrier xcd_barrier_post(unsigned* bar, volatile LAS unsigned* st) {
    XcdBarrier b; b.bar = bar; b.x = xb_xcc_id(); b.st = st;
    if (threadIdx.x == 0) (void)xb_add(&bar[XB_XCNT(b.x)], 1u);
    return b;
}
__device__ __forceinline__ void xcd_barrier_complete(unsigned* bar, unsigned x, unsigned& nloc, unsigned& nx) {
    const unsigned G = gridDim.x * gridDim.y * gridDim.z;
    unsigned sum, cnt, mine, sp = 0u;
    for (;;) {
        sum = 0u; cnt = 0u; mine = 0u;
#pragma unroll
        for (unsigned j = 0; j < 16; ++j) { const unsigned c = xb_ld(&bar[XB_XCNT(j)]); sum += c; cnt += (c > 0u) ? 1u : 0u; mine = (j == x) ? c : mine; }
        if (sum == G) break;
        __builtin_amdgcn_s_sleep(1);
        if ((++sp & 255u) == 0u) { if (xb_ld(&bar[XB_TMO])) break; if (sp > XB_SPIN_CAP) { atomicAdd(&bar[XB_TMO], 1u); break; } }
    }
    nloc = mine > 0u ? mine : 1u; nx = cnt > 0u ? cnt : 1u;
}
__device__ __forceinline__ void xcd_barrier(const XcdBarrier& b) {
    asm volatile("s_waitcnt vmcnt(0)" ::: "memory");
    __syncthreads();
    if (threadIdx.x == 0) {
        unsigned* bar = b.bar;
        __builtin_amdgcn_s_waitcnt(0);
        unsigned nloc = b.st[0], nx = b.st[1];
        if (nloc == 0u) { xcd_barrier_complete(bar, b.x, nloc, nx); b.st[0] = nloc; b.st[1] = nx; }
        const unsigned old = xb_add(&bar[XB_XSUB(b.x)], 1u);
        const unsigned gen = old / nloc;
        if (old + 1u == (gen + 1u) * nloc) {
            __builtin_amdgcn_fence(__ATOMIC_RELEASE, "agent");
            asm volatile("s_waitcnt vmcnt(0)" ::: "memory");
            const unsigned og = xb_add(&bar[XB_TOP], 1u);
            const unsigned tg = og / nx;
            if (og + 1u == (tg + 1u) * nx) xb_add(&bar[XB_TOPGEN], 1u);
            else XB_SPIN(xb_ld(&bar[XB_TOPGEN]) == tg, bar);
            __builtin_amdgcn_fence(__ATOMIC_ACQUIRE, "agent");
            xb_add(&bar[XB_XGEN(b.x)], 1u);
            asm volatile("s_waitcnt vmcnt(0)" ::: "memory");
        } else {
            XB_SPIN(xb_ld(&bar[XB_XGEN(b.x)]) == gen, bar);
            __builtin_amdgcn_fence(__ATOMIC_ACQUIRE, "agent");
            asm volatile("s_waitcnt vmcnt(0)" ::: "memory");
        }
    }
    __syncthreads();
}

struct Args {
    const float *x, *c, *w_ada, *b_ada, *norm1, *w_in, *pool_w, *pool_scale, *lb_logits, *hg_norm, *w_out, *norm2, *peer_wq, *peer_keys, *peer_u, *peer_v, *final_norm;
    float* out; unsigned char* ws; int ph_lo, ph_hi, li, pad;
};

struct EpiProj {
    static constexpr bool PERM = true;
    bf16 *P, *Q, *I, *GA, *GG; unsigned short* LF; const float* lb;
    __device__ __forceinline__ void operator()(const f32x4 (&acc)[2][2][4][2], const pg8::Unit& u, int wr, int wc, int fr, int fq) const {
        const int pn = u.pn, row0 = u.pm * 256 + wr * 64 + fr, cw = wc * 32 + 8 * fq;
        if (pn >= 36) {
            bf16* base = GG + (size_t)row0 * DM + (pn - 36) * 128 + cw;
#pragma unroll
            for (int ai = 0; ai < 2; ++ai)
#pragma unroll
                for (int m = 0; m < 4; ++m) {
                    float o[8];
#pragma unroll
                    for (int n = 0; n < 2; ++n)
#pragma unroll
                        for (int e = 0; e < 4; ++e) { const float gv = acc[ai][0][m][n][e], bv = acc[ai][1][m][n][e]; o[n * 4 + e] = gv * sigmoidf_(gv) * sigmoidf_(bv); }
                    v4u w; w.x = pk2(o[0], o[1]); w.y = pk2(o[2], o[3]); w.z = pk2(o[4], o[5]); w.w = pk2(o[6], o[7]);
                    *(v4u*)(base + (size_t)(ai * 128 + m * 16) * DM) = w;
                }
            return;
        }
        if (pn >= 12 && pn < 20) {
            const int cb = (pn - 12) * 256 + cw;
            float lbv[2][8];
#pragma unroll
            for (int bj = 0; bj < 2; ++bj) { const f32x4 a = *(const f32x4*)(lb + cb + bj * 128), b = *(const f32x4*)(lb + cb + bj * 128 + 4);
                lbv[bj][0] = a[0]; lbv[bj][1] = a[1]; lbv[bj][2] = a[2]; lbv[bj][3] = a[3]; lbv[bj][4] = b[0]; lbv[bj][5] = b[1]; lbv[bj][6] = b[2]; lbv[bj][7] = b[3]; }
            unsigned short* base = LF + (size_t)row0 * DM + cb;
#pragma unroll
            for (int ai = 0; ai < 2; ++ai)
#pragma unroll
                for (int m = 0; m < 4; ++m)
#pragma unroll
                    for (int bj = 0; bj < 2; ++bj) {
                        float o[8];
#pragma unroll
                        for (int n = 0; n < 2; ++n)
#pragma unroll
                            for (int e = 0; e < 4; ++e) { const float l = lbv[bj][n * 4 + e]; o[n * 4 + e] = __logf(l + (1.0f - l) * sigmoidf_(acc[ai][bj][m][n][e])); }
                        v4u w; w.x = pkh2(o[0], o[1]); w.y = pkh2(o[2], o[3]); w.z = pkh2(o[4], o[5]); w.w = pkh2(o[6], o[7]);
                        *(v4u*)(base + (size_t)(ai * 128 + m * 16) * DM + bj * 128) = w;
                    }
            return;
        }
        bf16* dst; int ldc, cb; bool sig = false;
        if (pn < 4) { dst = P; ldc = 1024; cb = pn * 256; }
        else if (pn < 12) { dst = Q; ldc = DM; cb = (pn - 4) * 256; }
        else if (pn < 28) { dst = I; ldc = DM; cb = (pn - 20) * 256; }
        else { dst = GA; ldc = DM; cb = (pn - 28) * 256; sig = true; }
        bf16* base = dst + (size_t)row0 * ldc + cb + cw;
#pragma unroll
        for (int ai = 0; ai < 2; ++ai)
#pragma unroll
            for (int m = 0; m < 4; ++m)
#pragma unroll
                for (int bj = 0; bj < 2; ++bj) {
                    f32x4 v0 = acc[ai][bj][m][0], v1 = acc[ai][bj][m][1];
                    if (sig) {
#pragma unroll
                        for (int e = 0; e < 4; ++e) { v0[e] = sigmoidf_(v0[e]); v1[e] = sigmoidf_(v1[e]); } }
                    v4u w; w.x = pk2(v0[0], v0[1]); w.y = pk2(v0[2], v0[3]); w.z = pk2(v1[0], v1[1]); w.w = pk2(v1[2], v1[3]);
                    *(v4u*)(base + (size_t)(ai * 128 + m * 16) * ldc + bj * 128) = w;
                }
    }
};
struct EpiPool {
    static constexpr bool PERM = true;
    bf16* YA; const bf16* GA; const float* pool_scale;
    __device__ __forceinline__ void operator()(const f32x4 (&acc)[2][2][4][2], const pg8::Unit& u, int wr, int wc, int fr, int fq) const {
        const int row0 = u.pm * 256 + wr * 64 + fr, col0 = u.pn * 256 + wc * 32 + 8 * fq;
        f32x4 ps[2][2];
#pragma unroll
        for (int bj = 0; bj < 2; ++bj)
#pragma unroll
            for (int n = 0; n < 2; ++n) ps[bj][n] = *(const f32x4*)(pool_scale + col0 + bj * 128 + 4 * n);
#pragma unroll
        for (int ai = 0; ai < 2; ++ai)
#pragma unroll
            for (int m = 0; m < 4; ++m) { const size_t off = (size_t)(row0 + ai * 128 + m * 16) * DM + col0;
#pragma unroll
                for (int bj = 0; bj < 2; ++bj) { const v4u gq = *(const v4u*)(GA + off + bj * 128);
                    const f32x4 v0 = acc[ai][bj][m][0] * ps[bj][0], v1 = acc[ai][bj][m][1] * ps[bj][1];
                    v4u w; w.x = pk2(v0[0] * bflo(gq.x), v0[1] * bfhi(gq.x)); w.y = pk2(v0[2] * bflo(gq.y), v0[3] * bfhi(gq.y));
                    w.z = pk2(v1[0] * bflo(gq.z), v1[1] * bfhi(gq.z)); w.w = pk2(v1[2] * bflo(gq.w), v1[3] * bfhi(gq.w));
                    *(v4u*)(YA + off + bj * 128) = w; } }
    }
};
struct EpiRes {
    static constexpr bool PERM = false;
    const float* x; float* x1; const float* ada; const float* b_ada;
    __device__ __forceinline__ void operator()(const f32x4 (&acc)[2][2][4][2], const pg8::Unit& u, int wr, int wc, int fr, int fq) const {
        const int row0 = u.pm * 256 + wr * 64 + fr, col0 = u.pn * 256 + wc * 32 + 4 * fq, b = u.pm >> 3;
        f32x4 gv[2][2];
#pragma unroll
        for (int bj = 0; bj < 2; ++bj)
#pragma unroll
            for (int n = 0; n < 2; ++n) { const int c = 2 * DM + col0 + bj * 128 + n * 16; gv[bj][n] = *(const f32x4*)(ada + (size_t)b * NADA + c) + 1.0f; }
#pragma unroll
        for (int ai = 0; ai < 2; ++ai)
#pragma unroll
            for (int m = 0; m < 4; ++m) { const size_t off = (size_t)(row0 + ai * 128 + m * 16) * DM + col0;
#pragma unroll
                for (int bj = 0; bj < 2; ++bj)
#pragma unroll
                    for (int n = 0; n < 2; ++n) { const f32x4 xv = *(const f32x4*)(x + off + bj * 128 + n * 16); *(f32x4*)(x1 + off + bj * 128 + n * 16) = xv + gv[bj][n] * acc[ai][bj][m][n]; }
                asm volatile("" ::: "memory"); }
    }
};
struct EpiBf16 {
    static constexpr bool PERM = true;
    bf16* O; int ldc;
    __device__ __forceinline__ void operator()(const f32x4 (&acc)[2][2][4][2], const pg8::Unit& u, int wr, int wc, int fr, int fq) const {
        const int row0 = u.pm * 256 + wr * 64 + fr, col0 = u.pn * 256 + wc * 32 + 8 * fq;
#pragma unroll
        for (int ai = 0; ai < 2; ++ai)
#pragma unroll
            for (int m = 0; m < 4; ++m) { bf16* rowp = O + (size_t)(row0 + ai * 128 + m * 16) * ldc + col0;
#pragma unroll
                for (int bj = 0; bj < 2; ++bj) { const f32x4 v0 = acc[ai][bj][m][0], v1 = acc[ai][bj][m][1];
                    v4u w; w.x = pk2(v0[0], v0[1]); w.y = pk2(v0[2], v0[3]); w.z = pk2(v1[0], v1[1]); w.w = pk2(v1[2], v1[3]);
                    *(v4u*)(rowp + bj * 128) = w; } }
    }
};

__device__ __forceinline__ void transpose_item(const float* W, int K, int N, bf16* WT, int ldt, int k0, int n0, int drow0, LAS float* scr, int lane) {
#pragma unroll 8
    for (int i = 0; i < 32; ++i) { const int kk = 2 * i + (lane >> 5); scr[kk * 33 + (lane & 31)] = W[(size_t)(k0 + kk) * N + n0 + (lane & 31)]; }
    LDS_WAIT(); asm volatile("" ::: "memory");
    const int c = lane & 7;
#pragma unroll
    for (int j = 0; j < 4; ++j) { const int n = (lane >> 3) + 8 * j; const LAS float* s = scr + (8 * c) * 33 + n;
        v4u o; o.x = pk2(s[0 * 33], s[1 * 33]); o.y = pk2(s[2 * 33], s[3 * 33]); o.z = pk2(s[4 * 33], s[5 * 33]); o.w = pk2(s[6 * 33], s[7 * 33]);
        *(GAS v4u*)(WT + (size_t)(drow0 + n) * ldt + k0 + 8 * c) = o; }
    LDS_WAIT(); asm volatile("" ::: "memory");
}
__device__ __forceinline__ int win_dst_row(int col) {
    if (col < 7168) return col;
    if (col < 9216) { const int r = col - 7168; return 9216 + (r >> 7) * 256 + (r & 127); }
    if (col < 11264) return 7168 + (col - 9216);
    { const int r = col - 11264; return 9216 + (r >> 7) * 256 + 128 + (r & 127); }
}
__device__ __forceinline__ void cvt_bf16_stream(const float* src, bf16* dst, size_t n, size_t gid, size_t gstride) {
    for (size_t i = gid * 8; i < n; i += gstride * 8) { const f32x4 a = *(const f32x4*)(src + i), b = *(const f32x4*)(src + i + 4);
        v4u w; w.x = pk2(a[0], a[1]); w.y = pk2(a[2], a[3]); w.z = pk2(b[0], b[1]); w.w = pk2(b[2], b[3]); *(v4u*)(dst + i) = w; }
}
__device__ __forceinline__ void phase_prologue(const Args& A, LAS unsigned char* lds) {
    const int tid = threadIdx.x, lane = tid & 63, wave = __builtin_amdgcn_readfirstlane(tid >> 6), G = gridDim.x;
    unsigned char* ws = A.ws;
    {
        LAS float* sc = (LAS float*)lds;
        LAS float* red = sc + 8 * DM;
        float* ada = (float*)(ws + WS_ADA);
        if ((int)blockIdx.x < NADA / 64) {
            for (int e = tid; e < 8 * DM; e += NTHR) { const float cv = A.c[e]; sc[e] = cv * sigmoidf_(cv); }
            __syncthreads();
        }
        for (int it = blockIdx.x; it < NADA / 64; it += G) {
            const int n = it * 64 + lane, k0 = wave * 256;
            float acc[8];
#pragma unroll
            for (int b = 0; b < 8; ++b) acc[b] = 0.f;
            for (int kk = 0; kk < 256; kk += 4) {
                float w[4];
#pragma unroll
                for (int j = 0; j < 4; ++j) w[j] = A.w_ada[(size_t)(k0 + kk + j) * NADA + n];
#pragma unroll
                for (int b = 0; b < 8; ++b) { const f32x4 s = *(const LAS f32x4*)(sc + b * DM + k0 + kk); acc[b] += s[0] * w[0] + s[1] * w[1] + s[2] * w[2] + s[3] * w[3]; }
            }
#pragma unroll
            for (int b = 0; b < 8; ++b) red[(wave * 8 + b) * 64 + lane] = acc[b];
            __syncthreads();
            { const int b = tid >> 6; float s = A.b_ada[n];
#pragma unroll
              for (int w8 = 0; w8 < 8; ++w8) s += red[(w8 * 8 + b) * 64 + lane];
              ada[b * NADA + n] = s; }
            __syncthreads();
        }
        __syncthreads();
    }
    {
        LAS float* scr = (LAS float*)(lds + wave * 16384);
        const int gw = blockIdx.x * NWAVES + wave, NGW = G * NWAVES;
        constexpr int I_IN = (DM / 64) * (NIN / 32), I_SQ = (DM / 64) * (DM / 32), I_PW = 4 * (256 / 64) * (512 / 32);
        for (int it = gw; it < I_IN + 2 * I_SQ + I_PW; it += NGW) {
            int r = it;
            if (r < I_IN) { const int nb = r % (NIN / 32), kb = r / (NIN / 32); transpose_item(A.w_in, DM, NIN, (bf16*)(ws + WS_WIN), DM, kb * 64, nb * 32, win_dst_row(nb * 32), scr, lane); continue; } r -= I_IN;
            if (r < I_SQ) { const int nb = r % (DM / 32), kb = r / (DM / 32); transpose_item(A.w_out, DM, DM, (bf16*)(ws + WS_WOUT), DM, kb * 64, nb * 32, nb * 32, scr, lane); continue; } r -= I_SQ;
            if (r < I_SQ) { const int nb = r % (DM / 32), kb = r / (DM / 32); transpose_item(A.peer_wq, DM, DM, (bf16*)(ws + WS_WQ), DM, kb * 64, nb * 32, nb * 32, scr, lane); continue; } r -= I_SQ;
            { const int g = r / 64, rr = r % 64, nb = rr % 16, kb = rr / 16;
              transpose_item(A.pool_w + (size_t)g * 256 * 512, 256, 512, (bf16*)(ws + WS_POOLW), 256, kb * 64, nb * 32, g * 512 + nb * 32, scr, lane); }
        }
    }
    {
        const size_t gid = (size_t)blockIdx.x * NTHR + tid, gs = (size_t)G * NTHR;
        cvt_bf16_stream(A.peer_keys, (bf16*)(ws + WS_KEYS), (size_t)8 * 2 * 128 * 128, gid, gs);
        cvt_bf16_stream(A.peer_u, (bf16*)(ws + WS_U), (size_t)T * DM, gid, gs);
        cvt_bf16_stream(A.peer_v, (bf16*)(ws + WS_V), (size_t)T * DM, gid, gs);
    }
    if (blockIdx.x == 0) { float* lb = (float*)(ws + WS_LB); for (int k = tid; k < DM; k += NTHR) lb[k] = sigmoidf_(A.lb_logits[k] - A.lb_logits[DM + k]); }
}

__device__ __forceinline__ void phase_modnorm(const float* xin, const float* gain, const float* ada, const float* b_ada, int soff, bf16* outp) {
    const int tid = threadIdx.x, lane = tid & 63, wave = tid >> 6;
    const int gw = blockIdx.x * NWAVES + wave, NGW = gridDim.x * NWAVES;
    for (int m = gw; m < T; m += NGW) {
        const int b = m / SEQ;
        const float* xr = xin + (size_t)m * DM;
        f32x4 v[8]; float s = 0.f;
#pragma unroll
        for (int j = 0; j < 8; ++j) { v[j] = *(const f32x4*)(xr + 4 * lane + 256 * j); s += (v[j][0] * v[j][0] + v[j][1] * v[j][1]) + (v[j][2] * v[j][2] + v[j][3] * v[j][3]); }
        const float rstd = 1.0f / sqrtf(wave_sum(s) * (1.0f / DM) + EPS);
        bf16* orow = outp + (size_t)m * DM;
#pragma unroll
        for (int j = 0; j < 8; ++j) { const int d = 4 * lane + 256 * j;
            const f32x4 gn = *(const f32x4*)(gain + d);
            const f32x4 sh = *(const f32x4*)(ada + (size_t)b * NADA + soff + d);
            const f32x4 sc = *(const f32x4*)(ada + (size_t)b * NADA + soff + DM + d) + 1.0f;
            const f32x4 o = v[j] * rstd * gn * sc + sh;
            v2u w; w.x = pk2(o[0], o[1]); w.y = pk2(o[2], o[3]); *(v2u*)(orow + d) = w; }
    }
}

__device__ __forceinline__ void phase_pool(const bf16* P, bf16* POOLED) {
    const size_t gid = (size_t)blockIdx.x * NTHR + threadIdx.x, gs = (size_t)gridDim.x * NTHR;
    for (size_t it = gid; it < (size_t)T * 128; it += gs) {
        const int t = (int)(it >> 7), ch = (int)(it & 127), g = ch >> 5, w = 2 << g, tl = t & (SEQ - 1), cnt = (tl + 1 < w) ? tl + 1 : w;
        const bf16* p = P + (size_t)t * 1024 + ch * 8;
        float s[8];
#pragma unroll
        for (int e = 0; e < 8; ++e) s[e] = 0.f;
        for (int k = 0; k < cnt; ++k) { const v4u q = *(const v4u*)(p - (size_t)k * 1024);
            s[0] += bflo(q.x); s[1] += bfhi(q.x); s[2] += bflo(q.y); s[3] += bfhi(q.y); s[4] += bflo(q.z); s[5] += bfhi(q.z); s[6] += bflo(q.w); s[7] += bfhi(q.w); }
        const v4u q0 = *(const v4u*)p; const float inv = 1.0f / (float)cnt;
        v4u o; o.x = pk2(s[0] * inv - bflo(q0.x), s[1] * inv - bfhi(q0.x)); o.y = pk2(s[2] * inv - bflo(q0.y), s[3] * inv - bfhi(q0.y));
        o.z = pk2(s[4] * inv - bflo(q0.z), s[5] * inv - bfhi(q0.z)); o.w = pk2(s[6] * inv - bflo(q0.w), s[7] * inv - bfhi(q0.w));
        *(v4u*)(POOLED + (size_t)t * 1024 + ch * 8) = o;
    }
}

__device__ __forceinline__ void phase_hgrn(const Args& A, LAS unsigned char* lds) {
    unsigned char* ws = A.ws;
    const bf16* Q = (const bf16*)(ws + WS_Q); const unsigned short* LF = (const unsigned short*)(ws + WS_LF); const bf16* I = (const bf16*)(ws + WS_I);
    const bf16* GG = (const bf16*)(ws + WS_GG); const bf16* YA = (const bf16*)(ws + WS_YA); bf16* MG = (bf16*)(ws + WS_MERGED);
    LAS float* sF = (LAS float*)lds; LAS float* sK = sF + 4096; LAS float* sQ = sK + 4096; LAS float* sI = sQ + 4096; LAS float* sO = sI + 4096;
    const int tid = threadIdx.x, v = tid & 127, kg = tid >> 7;
    for (int item = blockIdx.x; item < NBATCH * 16; item += gridDim.x) {
        const int b = item >> 4, h = item & 15;
        float S[32];
#pragma unroll
        for (int j = 0; j < 32; ++j) S[j] = 0.f;
        for (int tb = 0; tb < SEQ; tb += 32) {
            __syncthreads();
            for (int e = tid; e < 32 * 128; e += NTHR) { const int tt = e >> 7, c = e & 127; const size_t g = (size_t)(b * SEQ + tb + tt) * DM + h * 128 + c;
                const float f = __expf(h2f(LF[g])); sF[e] = f; sK[e] = 1.0f - f; sQ[e] = bf2f(Q[g]); sI[e] = bf2f(I[g]); }
            __syncthreads();
            for (int tt = 0; tt < 32; ++tt) {
                const float iv = sI[tt * 128 + v]; float part = 0.f;
                const LAS float* pf = sF + tt * 128 + kg * 32; const LAS float* pk = sK + tt * 128 + kg * 32; const LAS float* pq = sQ + tt * 128 + kg * 32;
#pragma unroll
                for (int j4 = 0; j4 < 8; ++j4) { const f32x4 f4 = *(const LAS f32x4*)(pf + 4 * j4), k4 = *(const LAS f32x4*)(pk + 4 * j4), q4 = *(const LAS f32x4*)(pq + 4 * j4);
#pragma unroll
                    for (int e = 0; e < 4; ++e) { S[4 * j4 + e] = f4[e] * S[4 * j4 + e] + k4[e] * iv; part += S[4 * j4 + e] * q4[e]; } }
                sO[(tt * 4 + kg) * 128 + v] = part;
            }
            __syncthreads();
            {
                const int tt = tid >> 4, l16 = tid & 15;
                float o[8]; float ssq = 0.f;
#pragma unroll
                for (int e = 0; e < 8; ++e) { o[e] = 0.f; }
#pragma unroll
                for (int k4 = 0; k4 < 4; ++k4) { const f32x4 a = *(const LAS f32x4*)(sO + (tt * 4 + k4) * 128 + 8 * l16), c = *(const LAS f32x4*)(sO + (tt * 4 + k4) * 128 + 8 * l16 + 4);
                    o[0] += a[0]; o[1] += a[1]; o[2] += a[2]; o[3] += a[3]; o[4] += c[0]; o[5] += c[1]; o[6] += c[2]; o[7] += c[3]; }
#pragma unroll
                for (int e = 0; e < 8; ++e) ssq += o[e] * o[e];
                ssq += __shfl_xor(ssq, 1); ssq += __shfl_xor(ssq, 2); ssq += __shfl_xor(ssq, 4); ssq += __shfl_xor(ssq, 8);
                const float rstd = 1.0f / sqrtf(ssq * (1.0f / 128.0f) + EPS);
                const int col = h * 128 + 8 * l16; const size_t g = (size_t)(b * SEQ + tb + tt) * DM + col;
                const f32x4 n0 = *(const f32x4*)(A.hg_norm + col), n1 = *(const f32x4*)(A.hg_norm + col + 4);
                const v4u gg = *(const v4u*)(GG + g), ya = *(const v4u*)(YA + g);
                v4u w;
                w.x = pk2(bflo(ya.x) + bflo(gg.x) * (o[0] * rstd * n0[0]), bfhi(ya.x) + bfhi(gg.x) * (o[1] * rstd * n0[1]));
                w.y = pk2(bflo(ya.y) + bflo(gg.y) * (o[2] * rstd * n0[2]), bfhi(ya.y) + bfhi(gg.y) * (o[3] * rstd * n0[3]));
                w.z = pk2(bflo(ya.z) + bflo(gg.z) * (o[4] * rstd * n1[0]), bfhi(ya.z) + bfhi(gg.z) * (o[5] * rstd * n1[1]));
                w.w = pk2(bflo(ya.w) + bflo(gg.w) * (o[6] * rstd * n1[2]), bfhi(ya.w) + bfhi(gg.w) * (o[7] * rstd * n1[3]));
                *(v4u*)(MG + g) = w;
            }
        }
        __syncthreads();
    }
}

__device__ __forceinline__ unsigned f2ord(float f) { const unsigned u = __builtin_bit_cast(unsigned, f); return u ^ ((u >> 31) ? 0xffffffffu : 0x80000000u); }
__device__ __forceinline__ float ord2f(unsigned o) { const unsigned u = o ^ ((o >> 31) ? 0x80000000u : 0xffffffffu); return __builtin_bit_cast(float, u); }
__device__ __forceinline__ float dot2bf(unsigned a, unsigned b, float c) { return c + bflo(a) * bflo(b) + bfhi(a) * bfhi(b); }
__device__ __forceinline__ void phase_route(const Args& A, LAS unsigned char* lds) {
    unsigned char* ws = A.ws;
    const bf16* QP = (const bf16*)(ws + WS_QP); const bf16* KB = (const bf16*)(ws + WS_KEYS);
    int* EIDX = (int*)(ws + WS_EIDX); float* GATE = (float*)(ws + WS_GATE);
    const int tid = threadIdx.x, p = tid & 1, tl = tid >> 1;
    constexpr int KOFF1 = 32768 + 16;
    for (int item = blockIdx.x; item < 64 * 8; item += gridDim.x) {
        const int tile = item >> 3, h = item & 7, t = tile * 256 + tl;
        __syncthreads();
        for (int e = tid; e < 4096; e += NTHR) { const int pp = e >> 11, r = e & 2047;
            *(LAS v4u*)(lds + pp * KOFF1 + r * 16) = *(const v4u*)(KB + (size_t)(h * 2 + pp) * 16384 + r * 8); }
        __syncthreads();
        unsigned q[64];
        { const v4u* qp = (const v4u*)(QP + (size_t)t * DM + h * 256 + p * 128);
#pragma unroll
          for (int j = 0; j < 16; ++j) { const v4u a = qp[j]; q[4 * j] = a.x; q[4 * j + 1] = a.y; q[4 * j + 2] = a.z; q[4 * j + 3] = a.w; } }
        unsigned top[16];
#pragma unroll
        for (int j = 0; j < 16; ++j) top[j] = 0u;
        const LAS unsigned char* kp = lds + p * KOFF1;
        for (int n = 0; n < 128; ++n) {
            float s0 = 0.f, s1 = 0.f;
#pragma unroll
            for (int j = 0; j < 16; ++j) { const v4u k4 = *(const LAS v4u*)(kp + n * 256 + j * 16);
                s0 = dot2bf(q[4 * j], k4.x, s0); s1 = dot2bf(q[4 * j + 1], k4.y, s1); s0 = dot2bf(q[4 * j + 2], k4.z, s0); s1 = dot2bf(q[4 * j + 3], k4.w, s1); }
            unsigned key = (f2ord(s0 + s1) & ~127u) | (unsigned)n;
#pragma unroll
            for (int j = 0; j < 16; ++j) { const unsigned hi = top[j] > key ? top[j] : key, lo = top[j] > key ? key : top[j]; top[j] = hi; key = lo; }
        }
        unsigned oth[16];
#pragma unroll
        for (int j = 0; j < 16; ++j) oth[j] = __shfl_xor(top[j], 1);
        float v0[16], v1[16]; int n0[16], n1[16];
#pragma unroll
        for (int j = 0; j < 16; ++j) { const unsigned a0 = p ? oth[j] : top[j], a1 = p ? top[j] : oth[j];
            v0[j] = ord2f(a0 & ~127u); n0[j] = (int)(a0 & 127u); v1[j] = ord2f(a1 & ~127u); n1[j] = (int)(a1 & 127u); }
        float ts[16]; int te[16];
#pragma unroll
        for (int j = 0; j < 16; ++j) { ts[j] = -3.0e38f; te[j] = 0; }
#pragma unroll
        for (int i = 0; i < 16; ++i)
#pragma unroll
            for (int j = 0; j < 16; ++j) if ((i + 1) * (j + 1) <= 16) {
                float s = v0[i] + v1[j]; int e = n0[i] * 128 + n1[j];
#pragma unroll
                for (int k = 0; k < 16; ++k) { const bool gt = s > ts[k]; const float fs = gt ? ts[k] : s; const int fe = gt ? te[k] : e; ts[k] = gt ? s : ts[k]; te[k] = gt ? e : te[k]; s = fs; e = fe; }
            }
        float ex[16], sum = 0.f;
#pragma unroll
        for (int k = 0; k < 16; ++k) { ex[k] = __expf(ts[k] - ts[0]); sum += ex[k]; }
        const float inv = 1.0f / sum;
        int* ep = EIDX + (size_t)t * 128 + h * 16 + 8 * p; float* gp = GATE + (size_t)t * 128 + h * 16 + 8 * p;
#pragma unroll
        for (int k = 0; k < 8; ++k) { const int kk = k + 8; ep[k] = p ? te[kk] : te[k]; gp[k] = (p ? ex[kk] : ex[k]) * inv; }
    }
}

__device__ __forceinline__ void phase_peer(const Args& A, LAS unsigned char* lds) {
    unsigned char* ws = A.ws;
    const bf16* H2 = (const bf16*)(ws + WS_H2); const bf16* UB = (const bf16*)(ws + WS_U); const bf16* VB = (const bf16*)(ws + WS_V);
    const int* EIDX = (const int*)(ws + WS_EIDX); const float* GATE = (const float*)(ws + WS_GATE);
    const float* ada = (const float*)(ws + WS_ADA);
    const int tid = threadIdx.x, lane = tid & 63, wave = tid >> 6, grp = lane >> 4, r = lane & 15;
    LAS float* sd = (LAS float*)lds + wave * 128;
    const int gw = blockIdx.x * NWAVES + wave, NGW = gridDim.x * NWAVES;
    for (int t = gw; t < T; t += NGW) {
        const int b = t / SEQ;
        const int e_lo = EIDX[(size_t)t * 128 + lane], e_hi = EIDX[(size_t)t * 128 + 64 + lane];
        const float g_lo = GATE[(size_t)t * 128 + lane], g_hi = GATE[(size_t)t * 128 + 64 + lane];
        v4u hq[16];
        { const v4u* hp = (const v4u*)(H2 + (size_t)t * DM) + r;
#pragma unroll
          for (int it = 0; it < 16; ++it) hq[it] = hp[16 * it]; }
        for (int qd = 0; qd < 32; ++qd) {
            const int eidx = 4 * qd + grp;
            const int e = __shfl((eidx < 64) ? e_lo : e_hi, eidx & 63);
            const v4u* up = (const v4u*)(UB + (size_t)e * DM) + r;
            float s0 = 0.f, s1 = 0.f;
#pragma unroll
            for (int it = 0; it < 16; ++it) { const v4u u4 = up[16 * it];
                s0 = dot2bf(hq[it].x, u4.x, s0); s1 = dot2bf(hq[it].y, u4.y, s1); s0 = dot2bf(hq[it].z, u4.z, s0); s1 = dot2bf(hq[it].w, u4.w, s1); }
            float s = s0 + s1;
            s += __shfl_xor(s, 1); s += __shfl_xor(s, 2); s += __shfl_xor(s, 4); s += __shfl_xor(s, 8);
            if (r == 0) sd[eidx] = s;
        }
        LDS_WAIT(); asm volatile("" ::: "memory");
        const float d_lo = sd[lane], d_hi = sd[64 + lane];
        LDS_WAIT(); asm volatile("" ::: "memory");
        const float w_lo = g_lo * 0.5f * d_lo * (1.0f + erff(d_lo * 0.70710678f)), w_hi = g_hi * 0.5f * d_hi * (1.0f + erff(d_hi * 0.70710678f));
        float y[32];
#pragma unroll
        for (int j = 0; j < 32; ++j) y[j] = 0.f;
        for (int eidx = 0; eidx < 128; ++eidx) {
            const int e = __builtin_amdgcn_readlane((eidx < 64) ? e_lo : e_hi, eidx & 63);
            const float w = __builtin_bit_cast(float, __builtin_amdgcn_readlane(__builtin_bit_cast(int, (eidx < 64) ? w_lo : w_hi), eidx & 63));
            const v4u* vp = (const v4u*)(VB + (size_t)e * DM) + lane;
#pragma unroll
            for (int j = 0; j < 4; ++j) { const v4u v4 = vp[64 * j];
                y[8 * j + 0] += w * bflo(v4.x); y[8 * j + 1] += w * bfhi(v4.x); y[8 * j + 2] += w * bflo(v4.y); y[8 * j + 3] += w * bfhi(v4.y);
                y[8 * j + 4] += w * bflo(v4.z); y[8 * j + 5] += w * bfhi(v4.z); y[8 * j + 6] += w * bflo(v4.w); y[8 * j + 7] += w * bfhi(v4.w); }
        }
        float* xr = A.out + (size_t)t * DM; float ssq = 0.f;
#pragma unroll
        for (int j = 0; j < 4; ++j) { const int d = 8 * lane + 512 * j;
#pragma unroll
            for (int hh = 0; hh < 2; ++hh) { const f32x4 xv = *(const f32x4*)(xr + d + 4 * hh);
                const f32x4 g2 = *(const f32x4*)(ada + (size_t)b * NADA + 5 * DM + d + 4 * hh) + 1.0f;
#pragma unroll
                for (int e = 0; e < 4; ++e) { const float x2 = xv[e] + g2[e] * y[8 * j + 4 * hh + e]; y[8 * j + 4 * hh + e] = x2; ssq += x2 * x2; } } }
        const float rstd = 1.0f / sqrtf(wave_sum(ssq) * (1.0f / DM) + EPS);
#pragma unroll
        for (int j = 0; j < 4; ++j) { const int d = 8 * lane + 512 * j;
#pragma unroll
            for (int hh = 0; hh < 2; ++hh) { const f32x4 fn = *(const f32x4*)(A.final_norm + d + 4 * hh);
                f32x4 o; o[0] = y[8 * j + 4 * hh] * rstd * fn[0]; o[1] = y[8 * j + 4 * hh + 1] * rstd * fn[1]; o[2] = y[8 * j + 4 * hh + 2] * rstd * fn[2]; o[3] = y[8 * j + 4 * hh + 3] * rstd * fn[3];
                *(f32x4*)(xr + d + 4 * hh) = o; } }
    }
}

__global__ void __launch_bounds__(NTHR, 2) fwd_kernel(Args args) {
    extern __shared__ __attribute__((aligned(16))) unsigned char lds_raw[];
    LAS unsigned char* lds = (LAS unsigned char*)lds_raw;
    volatile LAS unsigned* MISC = (volatile LAS unsigned*)(lds + MISC_OFF);
    const int tid = threadIdx.x, G = gridDim.x;
    unsigned char* ws = args.ws;
    for (int u = tid; u < (LDS_BYTES - LDSCTL_OFF) / 4; u += NTHR) ((LAS unsigned*)(lds + LDSCTL_OFF))[u] = 0u;
    __syncthreads();
    XcdBarrier bar; bar.bar = (unsigned*)(ws + WS_CTL) + CW_BAR; bar.x = 0; bar.st = nullptr;
    if (N_LAUNCHES == 1) bar = xcd_barrier_post((unsigned*)(ws + WS_CTL) + CW_BAR, MISC + 8);
    const int lo = args.ph_lo, hi = args.ph_hi;
#define IN(k) (lo <= (k) && (k) < hi)
#define SEAM(k) do { if (IN(k) && IN((k) + 1)) xcd_barrier(bar); } while (0)
    const float* ada = (const float*)(ws + WS_ADA);

    if (IN(0)) { phase_prologue(args, lds); } SEAM(0);
    if (IN(1)) { phase_modnorm(args.x, args.norm1, ada, args.b_ada, 0, (bf16*)(ws + WS_H1)); } SEAM(1);
    if (IN(2)) {
        pg8::Gemm g{(const bf16*)(ws + WS_H1), (const bf16*)(ws + WS_WIN), T, NIN, DM, DM, DM, 30, 0}; pg8::StaticOrder S; S.init(T, NIN, G, (int)blockIdx.x);
        EpiProj E{(bf16*)(ws + WS_P), (bf16*)(ws + WS_Q), (bf16*)(ws + WS_I), (bf16*)(ws + WS_GA), (bf16*)(ws + WS_GG), (unsigned short*)(ws + WS_LF), (const float*)(ws + WS_LB)};
        pg8::gemm_phase<EpiProj, true>(lds, g, S, E);
    } SEAM(2);
    if (IN(3)) { phase_pool((const bf16*)(ws + WS_P), (bf16*)(ws + WS_POOLED)); } SEAM(3);
    if (IN(4)) {
        pg8::Gemm g{(const bf16*)(ws + WS_POOLED), (const bf16*)(ws + WS_POOLW), T, DM, 256, 1024, 256, 1, 256}; pg8::StaticOrder S; S.init(T, DM, G, (int)blockIdx.x);
        EpiPool E{(bf16*)(ws + WS_YA), (const bf16*)(ws + WS_GA), args.pool_scale};
        pg8::gemm_phase<EpiPool, true>(lds, g, S, E);
    } SEAM(4);
    if (IN(5)) { phase_hgrn(args, lds); } SEAM(5);
    if (IN(6)) {
        pg8::Gemm g{(const bf16*)(ws + WS_MERGED), (const bf16*)(ws + WS_WOUT), T, DM, DM, DM, DM, 30, 0}; pg8::StaticOrder S; S.init(T, DM, G, (int)blockIdx.x);
        EpiRes E{args.x, args.out, ada, args.b_ada};
        pg8::gemm_phase<EpiRes, true>(lds, g, S, E);
    } SEAM(6);
    if (IN(7)) { phase_modnorm(args.out, args.norm2, ada, args.b_ada, 3 * DM, (bf16*)(ws + WS_H2)); } SEAM(7);
    if (IN(8)) {
        pg8::Gemm g{(const bf16*)(ws + WS_H2), (const bf16*)(ws + WS_WQ), T, DM, DM, DM, DM, 30, 0}; pg8::StaticOrder S; S.init(T, DM, G, (int)blockIdx.x);
        EpiBf16 E{(bf16*)(ws + WS_QP), DM};
        pg8::gemm_phase<EpiBf16, true>(lds, g, S, E);
    } SEAM(8);
    if (IN(9)) { phase_route(args, lds); } SEAM(9);
    if (IN(10)) { phase_peer(args, lds); }
#undef IN
#undef SEAM
}

extern "C" void kernel_launch(void* const* d_in, const int* in_sizes, int n_in, void* d_out, int out_size, void* d_ws, size_t ws_size, hipStream_t stream) {
    static int grid = 0;
    if (grid == 0) {
        if (n_in != 17 || in_sizes[0] != T * DM || out_size != T * DM || ws_size < WS_END) {
            fprintf(stderr, "kernel_launch: unexpected shapes (n_in %d, in0 %d, out %d, ws %zu < %zu); nothing launched\n", n_in, n_in > 0 ? in_sizes[0] : -1, out_size, ws_size, (size_t)WS_END); grid = -1; return; }
        int dev = 0, cus = 0, per_cu = 0;
        if (hipGetDevice(&dev) != hipSuccess || hipDeviceGetAttribute(&cus, hipDeviceAttributeMultiprocessorCount, dev) != hipSuccess) { fprintf(stderr, "kernel_launch: device query failed\n"); grid = -1; return; }
        if (hipFuncSetAttribute((const void*)fwd_kernel, hipFuncAttributeMaxDynamicSharedMemorySize, LDS_BYTES) != hipSuccess) { fprintf(stderr, "kernel_launch: hipFuncSetAttribute failed\n"); grid = -1; return; }
        if (hipOccupancyMaxActiveBlocksPerMultiprocessor(&per_cu, (const void*)fwd_kernel, NTHR, LDS_BYTES) != hipSuccess || per_cu < 1) { fprintf(stderr, "kernel_launch: occupancy query reports %d blocks per CU\n", per_cu); }
        (void)hipGetLastError();
        grid = cus;
    }
    if (grid < 0) return;
    (void)hipMemsetAsync((char*)d_ws + WS_CTL, 0, CTL_ZERO_BYTES, stream);
    Args a{};
    a.x = (const float*)d_in[0]; a.c = (const float*)d_in[1]; a.w_ada = (const float*)d_in[2]; a.b_ada = (const float*)d_in[3]; a.norm1 = (const float*)d_in[4];
    a.w_in = (const float*)d_in[5]; a.pool_w = (const float*)d_in[6]; a.pool_scale = (const float*)d_in[7]; a.lb_logits = (const float*)d_in[8]; a.hg_norm = (const float*)d_in[9];
    a.w_out = (const float*)d_in[10]; a.norm2 = (const float*)d_in[11]; a.peer_wq = (const float*)d_in[12]; a.peer_keys = (const float*)d_in[13]; a.peer_u = (const float*)d_in[14];
    a.peer_v = (const float*)d_in[15]; a.final_norm = (const float*)d_in[16];
    a.out = (float*)d_out; a.ws = (unsigned char*)d_ws;
    if (N_LAUNCHES == 1) {
        a.ph_lo = 0; a.ph_hi = N_PHASES; a.li = 0;
        hipLaunchKernelGGL(fwd_kernel, dim3(grid), dim3(NTHR), LDS_BYTES, stream, a);
    } else {
        for (int li = 0; li < N_PHASES; ++li) { a.ph_lo = li; a.ph_hi = li + 1; a.li = li; hipLaunchKernelGGL(fwd_kernel, dim3(grid), dim3(NTHR), LDS_BYTES, stream, a); }
    }
    const hipError_t le = hipPeekAtLastError();
    if (le != hipSuccess) fprintf(stderr, "kernel_launch: launch failed: %s\n", hipGetErrorName(le));
}
```

```cpp
#include <hip/hip_runtime.h>
#include <cstdio>
#include <cstdint>

#ifndef MK_N_LAUNCHES
#define MK_N_LAUNCHES 1
#endif

namespace pg8 {
#define PG8_LAS __attribute__((address_space(3)))
typedef unsigned short bf16_t;
typedef short bf16x8 __attribute__((ext_vector_type(8)));
typedef float f32x4 __attribute__((ext_vector_type(4)));
typedef unsigned u32x4 __attribute__((ext_vector_type(4)));
constexpr int BM = 256, BK = 64, HALF = 128, HTB = HALF * BK * 2  , STAGE_BYTES = 8 * HTB, NXCD = 8, WGM = 8;

__host__ __device__ __forceinline__ int lds_byte(int r, int c) { const int st = (r >> 4) * 2 + (c >> 5), rr = r & 15, cc = c & 31, ob = rr * 64 + cc * 2; return st * 1024 + (ob ^ (((ob >> 9) & 1) << 5)); }
__host__ __device__ __forceinline__ void stage_rc(int b, int& R, int& C) { const int st = b / 1024, sb = b % 1024, swz = sb ^ (((sb >> 9) & 1) << 5); R = (st >> 1) * 16 + swz / 64; C = (st & 1) * 32 + (swz % 64) / 2; }
__host__ __device__ __forceinline__ int perm32(int rho) { const int n = rho >> 4, i = rho & 15; return 8 * (i >> 2) + 4 * n + (i & 3); }

struct Unit { int pm, pn; };
struct Gemm { const bf16_t* A; const bf16_t* Bt; int M, N, K, lda, ldb, a_gshift, a_gstride; };

struct StaticOrder {
    int nM, nN, nwg, G, c;
    __host__ __device__ void init(int M, int N, int G_, int c_) { nM = M / BM; nN = N / BM; nwg = nM * nN; G = G_; c = c_; }
    __host__ __device__ bool next(int i, Unit& u) const {
        const long L = (long)i * G + c; if (L >= nwg) return false;
        int wgid = (int)L; { const int q = nwg / NXCD, r = nwg % NXCD, xcd = wgid % NXCD, off = wgid / NXCD; wgid = (xcd < r ? xcd * (q + 1) : r * (q + 1) + (xcd - r) * q) + off; }
        const int nig = WGM * nN, gid = wgid / nig, fm = gid * WGM, gsz = (nM - fm) < WGM ? (nM - fm) : WGM;
        u.pm = fm + ((wgid % nig) % gsz); u.pn = (wgid % nig) / gsz; return true;
    }
};

__device__ __forceinline__ unsigned cvt_pk_bf16(float lo, float hi) { unsigned r; asm volatile("v_cvt_pk_bf16_f32 %0, %1, %2" : "=v"(r) : "v"(lo), "v"(hi)); return r; }

template <class Epi, bool ALIGN_EPI>
__device__ __forceinline__ void gemm_phase(PG8_LAS unsigned char* lds, const Gemm g, const StaticOrder& S, const Epi& E) {
    const int tid = threadIdx.x, wid = __builtin_amdgcn_readfirstlane(tid >> 6), lane = tid & 63, wr = wid >> 2, wc = wid & 3, fr = lane & 15, fq = lane >> 4;
    const int K = g.K, nt = K / BK;
    unsigned voffA[2], voffB[2];
#pragma unroll
    for (int i = 0; i < 2; ++i) { int R, C; stage_rc(tid * 16 + i * 8192, R, C); const int Rb = Epi::PERM ? ((R & ~31) + perm32(R & 31)) : R;
        voffA[i] = (unsigned)(R * g.lda + C) * 2u; voffB[i] = (unsigned)(Rb * g.ldb + C) * 2u; }
    const size_t kstep = (size_t)(BK * 2);
    const size_t hstepA = (size_t)HALF * g.lda * 2, hstepB = (size_t)HALF * g.ldb * 2;
    const size_t tstepA = 2 * hstepA, tstepB = 2 * hstepB;
    const unsigned ldsw = (unsigned)wid * 1024u;
    const int aoff = lds_byte(wr * 64 + fr, fq * 8), boff = lds_byte(wc * 32 + fr, fq * 8);
#define PG8_SA(b, h) (((b) * 2 + (h)) * HTB)
#define PG8_SB(b, h) ((4 + (b) * 2 + (h)) * HTB)
#define PG8_STAGE(bufoff, gbase, voff) do { _Pragma("unroll") for (int _i = 0; _i < 2; ++_i) \
        __builtin_amdgcn_global_load_lds((const unsigned*)((const char*)(gbase) + (voff)[_i]), (PG8_LAS unsigned*)(lds + (bufoff) + ldsw + _i * 8192), 16, 0, 0); } while (0)
#define PG8_LDA(dst, b, h) do { _Pragma("unroll") for (int m = 0; m < 4; ++m) _Pragma("unroll") for (int k = 0; k < 2; ++k) dst[m][k] = *(const PG8_LAS bf16x8*)(lds + PG8_SA(b, h) + aoff + m * 2048 + k * 1024); } while (0)
#define PG8_LDB(dst, b, h) do { _Pragma("unroll") for (int n = 0; n < 2; ++n) _Pragma("unroll") for (int k = 0; k < 2; ++k) dst[n][k] = *(const PG8_LAS bf16x8*)(lds + PG8_SB(b, h) + boff + n * 2048 + k * 1024); } while (0)
#define PG8_MMA(ai, bj, At, Bt) do { __builtin_amdgcn_s_setprio(1); _Pragma("unroll") for (int m = 0; m < 4; ++m) _Pragma("unroll") for (int n = 0; n < 2; ++n) _Pragma("unroll") for (int k = 0; k < 2; ++k) \
        acc[ai][bj][m][n] = __builtin_amdgcn_mfma_f32_16x16x32_bf16(Bt[n][k], At[m][k], acc[ai][bj][m][n], 0, 0, 0); __builtin_amdgcn_s_setprio(0); } while (0)
#define PG8_WAIT_V(n) asm volatile("s_waitcnt vmcnt(" #n ")" ::: "memory")
#define PG8_WAIT_L(n) asm volatile("s_waitcnt lgkmcnt(" #n ")" ::: "memory")
#define PG8_BAR __builtin_amdgcn_s_barrier()
#define PG8_SCHED __builtin_amdgcn_sched_barrier(0)
#define PG8_UA(u) ((const char*)g.A + (size_t)(u).pm * tstepA + (size_t)(((u).pn >> g.a_gshift) * g.a_gstride) * 2)
#define PG8_UB(u) ((const char*)g.Bt + (size_t)(u).pn * tstepB)
    Unit cur, nxt; int ui = 0;
    if (!S.next(0, cur)) return;
    f32x4 acc[2][2][4][2];
#pragma unroll
    for (int a = 0; a < 2; ++a)
#pragma unroll
        for (int b = 0; b < 2; ++b)
#pragma unroll
            for (int m = 0; m < 4; ++m)
#pragma unroll
                for (int n = 0; n < 2; ++n) acc[a][b][m][n] = (f32x4){0.f, 0.f, 0.f, 0.f};
    bf16x8 At[4][2], B0[2][2], B1[2][2];
    const char* cA = PG8_UA(cur); const char* cB = PG8_UB(cur);
    PG8_STAGE(PG8_SB(0, 0), cB, voffB); PG8_STAGE(PG8_SB(0, 1), cB + hstepB, voffB); PG8_STAGE(PG8_SA(0, 0), cA, voffA); PG8_STAGE(PG8_SA(0, 1), cA + hstepA, voffA);
    if (wr == 1) PG8_BAR;
    PG8_WAIT_V(2); PG8_BAR;
    PG8_STAGE(PG8_SB(1, 0), cB + kstep, voffB); PG8_STAGE(PG8_SA(1, 0), cA + kstep, voffA); PG8_STAGE(PG8_SB(1, 1), cB + hstepB + kstep, voffB);
    PG8_WAIT_V(6); PG8_BAR;
    for (;;) {
        const bool has_next = S.next(ui + 1, nxt);
        const char* nA = has_next ? PG8_UA(nxt) : cA; const char* nB = has_next ? PG8_UB(nxt) : cB;
        for (int t = 0; t < nt; t += 2) {
            const bool last = (t == nt - 2);
            const char* a1 = cA + (size_t)(t + 1) * kstep;
            const char* a2 = last ? nA : cA + (size_t)(t + 2) * kstep; const char* b2 = last ? nB : cB + (size_t)(t + 2) * kstep;
            const char* a3 = a2 + kstep; const char* b3 = b2 + kstep;
            PG8_LDB(B0, 0, 0); PG8_LDB(B1, 0, 1); PG8_SCHED; PG8_LDA(At, 0, 0); PG8_STAGE(PG8_SA(1, 1), a1 + hstepA, voffA);
            PG8_WAIT_V(8); PG8_WAIT_L(0); PG8_BAR; PG8_MMA(0, 0, At, B0); PG8_MMA(0, 1, At, B1); PG8_BAR; PG8_SCHED;
            PG8_LDA(At, 0, 1); PG8_STAGE(PG8_SB(0, 0), b2, voffB); PG8_STAGE(PG8_SB(0, 1), b2 + hstepB, voffB); PG8_STAGE(PG8_SA(0, 0), a2, voffA);
            PG8_WAIT_V(8); PG8_WAIT_L(0); PG8_BAR; PG8_MMA(1, 0, At, B0); PG8_MMA(1, 1, At, B1); PG8_BAR; PG8_SCHED;
            PG8_LDB(B0, 1, 0); PG8_LDB(B1, 1, 1); PG8_SCHED; PG8_LDA(At, 1, 0); PG8_STAGE(PG8_SA(0, 1), a2 + hstepA, voffA);
            PG8_WAIT_V(8); PG8_WAIT_L(0); PG8_BAR; PG8_MMA(0, 0, At, B0); PG8_MMA(0, 1, At, B1); PG8_BAR; PG8_SCHED;
            PG8_LDA(At, 1, 1); PG8_STAGE(PG8_SB(1, 0), b3, voffB); PG8_STAGE(PG8_SB(1, 1), b3 + hstepB, voffB); PG8_STAGE(PG8_SA(1, 0), a3, voffA);
            PG8_WAIT_V(8); PG8_WAIT_L(0); PG8_BAR; PG8_MMA(1, 0, At, B0); PG8_MMA(1, 1, At, B1); PG8_BAR; PG8_SCHED;
        }
        if constexpr (ALIGN_EPI) { if (wr == 0) PG8_BAR; }
        E(acc, cur, wr, wc, fr, fq);
        if (!has_next) break;
#pragma unroll
        for (int a = 0; a < 2; ++a)
#pragma unroll
            for (int b = 0; b < 2; ++b)
#pragma unroll
                for (int m = 0; m < 4; ++m)
#pragma unroll
                    for (int n = 0; n < 2; ++n) acc[a][b][m][n] = (f32x4){0.f, 0.f, 0.f, 0.f};
        cur = nxt; cA = nA; cB = nB; ++ui;
        if constexpr (ALIGN_EPI) { if (wr == 1) PG8_BAR; }
    }
    PG8_WAIT_V(0);
    if constexpr (!ALIGN_EPI) { if (wr == 0) PG8_BAR; }
    PG8_BAR;
#undef PG8_SA
#undef PG8_SB
#undef PG8_STAGE
#undef PG8_LDA
#undef PG8_LDB
#undef PG8_MMA
#undef PG8_WAIT_V
#undef PG8_WAIT_L
#undef PG8_BAR
#undef PG8_SCHED
#undef PG8_UA
#undef PG8_UB
}
}

constexpr int NWAVES = 8, NTHR = 512;
constexpr int T = 16384, DM = 2048, SEQ = 2048, NBATCH = 8, NIN = 13312, NADA = 12288;
constexpr int N_PHASES = 11;
constexpr int N_LAUNCHES = MK_N_LAUNCHES;
constexpr float EPS = 1e-6f;

constexpr size_t MiB = 1u << 20;
constexpr size_t WS_CTL = 0, CTL_ZERO_BYTES = 1 * MiB;
constexpr size_t WS_ADA = 512 * 1024;
constexpr size_t WS_WOUT = 1 * MiB, WS_WQ = 9 * MiB, WS_POOLW = 17 * MiB, WS_KEYS = 18 * MiB, WS_LB = 19 * MiB;
constexpr size_t WS_WIN = 20 * MiB, WS_H1 = 72 * MiB, WS_P = 136 * MiB, WS_GA = 168 * MiB, WS_Q = 232 * MiB, WS_LF = 296 * MiB, WS_I = 360 * MiB, WS_GG = 424 * MiB;
constexpr size_t WS_U = 488 * MiB, WS_V = 552 * MiB, WS_END = 616 * MiB;
constexpr size_t WS_POOLED = 20 * MiB, WS_YA = 72 * MiB, WS_MERGED = 136 * MiB, WS_H2 = 232 * MiB, WS_QP = 296 * MiB, WS_EIDX = 360 * MiB, WS_GATE = 368 * MiB;
constexpr int CW_BAR = 4096;

constexpr int RING_BYTES = 131072;
constexpr int LDSCTL_OFF = RING_BYTES, MISC_OFF = LDSCTL_OFF + 320;
constexpr int LDS_BYTES = 147456;

#define GAS __attribute__((address_space(1)))
#define LAS __attribute__((address_space(3)))
typedef unsigned short bf16;
typedef unsigned v4u __attribute__((ext_vector_type(4)));
typedef unsigned v2u __attribute__((ext_vector_type(2)));
typedef float f32x4 __attribute__((ext_vector_type(4)));
typedef GAS unsigned gu32;
#define RLX_AGENT __ATOMIC_RELAXED, __HIP_MEMORY_SCOPE_AGENT
#define LDS_WAIT() asm volatile("s_waitcnt lgkmcnt(0)" ::: "memory")
__device__ __forceinline__ unsigned f2bf(float f) { unsigned u = __builtin_bit_cast(unsigned, f); return (u + 0x7fffu + ((u >> 16) & 1u)) >> 16; }
__device__ __forceinline__ unsigned pk2(float lo, float hi) { return pg8::cvt_pk_bf16(lo, hi); }
__device__ __forceinline__ float bflo(unsigned w) { return __builtin_bit_cast(float, w << 16); }
__device__ __forceinline__ float bfhi(unsigned w) { return __builtin_bit_cast(float, w & 0xffff0000u); }
__device__ __forceinline__ float bf2f(bf16 b) { return __builtin_bit_cast(float, ((unsigned)b) << 16); }
__device__ __forceinline__ unsigned pkh2(float a, float b) { const _Float16 ha = (_Float16)a, hb = (_Float16)b; return (unsigned)__builtin_bit_cast(unsigned short, ha) | ((unsigned)__builtin_bit_cast(unsigned short, hb) << 16); }
__device__ __forceinline__ float h2f(unsigned short h) { return (float)__builtin_bit_cast(_Float16, h); }
__device__ __forceinline__ float sigmoidf_(float z) { return 1.0f / (1.0f + __expf(-z)); }
__device__ __forceinline__ float wave_sum(float v) {
#pragma unroll
    for (int o = 1; o < 64; o <<= 1) v += __shfl_xor(v, o);
    return v;
}

#define XB_TMO      128
#define XB_XCNT(j)  (256  + 64 * (j))
#define XB_XSUB(j)  (1280 + 64 * (j))
#define XB_XGEN(j)  (2304 + 64 * (j))
#define XB_TOP      3328
#define XB_TOPGEN   3392
#define XCD_BAR_WORDS 3456
#define XB_SPIN_CAP (1u << 18)
__device__ __forceinline__ unsigned xb_ld(unsigned* p)              { return __hip_atomic_load(p, __ATOMIC_RELAXED, __HIP_MEMORY_SCOPE_AGENT); }
__device__ __forceinline__ unsigned xb_add(unsigned* p, unsigned v) { return __hip_atomic_fetch_add(p, v, __ATOMIC_RELAXED, __HIP_MEMORY_SCOPE_AGENT); }
__device__ __forceinline__ unsigned xb_xcc_id() { return (unsigned)__builtin_amdgcn_s_getreg((3 << 11) | 20) & 0xFu; }
#define XB_SPIN(cond, bar) do { unsigned _sp = 0; while (cond) { __builtin_amdgcn_s_sleep(1); \
    if ((++_sp & 255u) == 0u) { if (xb_ld(&(bar)[XB_TMO])) break; if (_sp > XB_SPIN_CAP) { atomicAdd(&(bar)[XB_TMO], 1u); break; } } } } while (0)
struct XcdBarrier { unsigned* bar; unsigned x; volatile LAS unsigned* st; };
__device__ __forceinline__ XcdBarrier xcd_barrier_post(unsigned* bar, volatile LAS unsigned* st) {
    XcdBarrier b; b.bar = bar; b.x = xb_xcc_id(); b.st = st;
    if (threadIdx.x == 0) (void)xb_add(&bar[XB_XCNT(b.x)], 1u);
    return b;
}
__device__ __forceinline__ void xcd_barrier_complete(unsigned* bar, unsigned x, unsigned& nloc, unsigned& nx) {
    const unsigned G = gridDim.x * gridDim.y * gridDim.z;
    unsigned sum, cnt, mine, sp = 0u;
    for (;;) {
        sum = 0u; cnt = 0u; mine = 0u;
#pragma unroll
        for (unsigned j = 0; j < 16; ++j) { const unsigned c = xb_ld(&bar[XB_XCNT(j)]); sum += c; cnt += (c > 0u) ? 1u : 0u; mine = (j == x) ? c : mine; }
        if (sum == G) break;
        __builtin_amdgcn_s_sleep(1);
        if ((++sp & 255u) == 0u) { if (xb_ld(&bar[XB_TMO])) break; if (sp > XB_SPIN_CAP) { atomicAdd(&bar[XB_TMO], 1u); break; } }
    }
    nloc = mine > 0u ? mine : 1u; nx = cnt > 0u ? cnt : 1u;
}
__device__ __forceinline__ void xcd_barrier(const XcdBarrier& b) {
    asm volatile("s_waitcnt vmcnt(0)" ::: "memory");
    __syncthreads();
    if (threadIdx.x == 0) {
        unsigned* bar = b.bar;
        __builtin_amdgcn_s_waitcnt(0);
        unsigned nloc = b.st[0], nx = b.st[1];
        if (nloc == 0u) { xcd_barrier_complete(bar, b.x, nloc, nx); b.st[0] = nloc; b.st[1] = nx; }
        const unsigned old = xb_add(&bar[XB_XSUB(b.x)], 1u);
        const unsigned gen = old / nloc;
        if (old + 1u == (gen + 1u) * nloc) {
            __builtin_amdgcn_fence(__ATOMIC_RELEASE, "agent");
            asm volatile("s_waitcnt vmcnt(0)" ::: "memory");
            const unsigned og = xb_add(&bar[XB_TOP], 1u);
            const unsigned tg = og / nx;
            if (og + 1u == (tg + 1u) * nx) xb_add(&bar[XB_TOPGEN], 1u);
            else XB_SPIN(xb_ld(&bar[XB_TOPGEN]) == tg, bar);
            __builtin_amdgcn_fence(__ATOMIC_ACQUIRE, "agent");
            xb_add(&bar[XB_XGEN(b.x)], 1u);
            asm volatile("s_waitcnt vmcnt(0)" ::: "memory");
        } else {
            XB_SPIN(xb_ld(&bar[XB_XGEN(b.x)]) == gen, bar);
            __builtin_amdgcn_fence(__ATOMIC_ACQUIRE, "agent");
            asm volatile("s_waitcnt vmcnt(0)" ::: "memory");
        }
    }
    __syncthreads();
}

struct Args {
    const float *x, *c, *w_ada, *b_ada, *norm1, *w_in, *pool_w, *pool_scale, *lb_logits, *hg_norm, *w_out, *norm2, *peer_wq, *peer_keys, *peer_u, *peer_v, *final_norm;
    float* out; unsigned char* ws; int ph_lo, ph_hi, li, pad;
};

struct EpiProj {
    static constexpr bool PERM = true;
    bf16 *P, *Q, *I, *GA, *GG; unsigned short* LF; const float* lb;
    __device__ __forceinline__ void operator()(const f32x4 (&acc)[2][2][4][2], const pg8::Unit& u, int wr, int wc, int fr, int fq) const {
        const int pn = u.pn, row0 = u.pm * 256 + wr * 64 + fr, cw = wc * 32 + 8 * fq;
        if (pn >= 36) {
            bf16* base = GG + (size_t)row0 * DM + (pn - 36) * 128 + cw;
#pragma unroll
            for (int ai = 0; ai < 2; ++ai)
#pragma unroll
                for (int m = 0; m < 4; ++m) {
                    float o[8];
#pragma unroll
                    for (int n = 0; n < 2; ++n)
#pragma unroll
                        for (int e = 0; e < 4; ++e) { const float gv = acc[ai][0][m][n][e], bv = acc[ai][1][m][n][e]; o[n * 4 + e] = gv * sigmoidf_(gv) * sigmoidf_(bv); }
                    v4u w; w.x = pk2(o[0], o[1]); w.y = pk2(o[2], o[3]); w.z = pk2(o[4], o[5]); w.w = pk2(o[6], o[7]);
                    *(v4u*)(base + (size_t)(ai * 128 + m * 16) * DM) = w;
                }
            return;
        }
        if (pn >= 12 && pn < 20) {
            const int cb = (pn - 12) * 256 + cw;
            float lbv[2][8];
#pragma unroll
            for (int bj = 0; bj < 2; ++bj) { const f32x4 a = *(const f32x4*)(lb + cb + bj * 128), b = *(const f32x4*)(lb + cb + bj * 128 + 4);
                lbv[bj][0] = a[0]; lbv[bj][1] = a[1]; lbv[bj][2] = a[2]; lbv[bj][3] = a[3]; lbv[bj][4] = b[0]; lbv[bj][5] = b[1]; lbv[bj][6] = b[2]; lbv[bj][7] = b[3]; }
            unsigned short* base = LF + (size_t)row0 * DM + cb;
#pragma unroll
            for (int ai = 0; ai < 2; ++ai)
#pragma unroll
                for (int m = 0; m < 4; ++m)
#pragma unroll
                    for (int bj = 0; bj < 2; ++bj) {
                        float o[8];
#pragma unroll
                        for (int n = 0; n < 2; ++n)
#pragma unroll
                            for (int e = 0; e < 4; ++e) { const float l = lbv[bj][n * 4 + e]; o[n * 4 + e] = __logf(l + (1.0f - l) * sigmoidf_(acc[ai][bj][m][n][e])); }
                        v4u w; w.x = pkh2(o[0], o[1]); w.y = pkh2(o[2], o[3]); w.z = pkh2(o[4], o[5]); w.w = pkh2(o[6], o[7]);
                        *(v4u*)(base + (size_t)(ai * 128 + m * 16) * DM + bj * 128) = w;
                    }
            return;
        }
        bf16* dst; int ldc, cb; bool sig = false;
        if (pn < 4) { dst = P; ldc = 1024; cb = pn * 256; }
        else if (pn < 12) { dst = Q; ldc = DM; cb = (pn - 4) * 256; }
        else if (pn < 28) { dst = I; ldc = DM; cb = (pn - 20) * 256; }
        else { dst = GA; ldc = DM; cb = (pn - 28) * 256; sig = true; }
        bf16* base = dst + (size_t)row0 * ldc + cb + cw;
#pragma unroll
        for (int ai = 0; ai < 2; ++ai)
#pragma unroll
            for (int m = 0; m < 4; ++m)
#pragma unroll
                for (int bj = 0; bj < 2; ++bj) {
                    f32x4 v0 = acc[ai][bj][m][0], v1 = acc[ai][bj][m][1];
                    if (sig) {
#pragma unroll
                        for (int e = 0; e < 4; ++e) { v0[e] = sigmoidf_(v0[e]); v1[e] = sigmoidf_(v1[e]); } }
                    v4u w; w.x = pk2(v0[0], v0[1]); w.y = pk2(v0[2], v0[3]); w.z = pk2(v1[0], v1[1]); w.w = pk2(v1[2], v1[3]);
                    *(v4u*)(base + (size_t)(ai * 128 + m * 16) * ldc + bj * 128) = w;
                }
    }
};
struct EpiPool {
    static constexpr bool PERM = true;
    bf16* YA; const bf16* GA; const float* pool_scale;
    __device__ __forceinline__ void operator()(const f32x4 (&acc)[2][2][4][2], const pg8::Unit& u, int wr, int wc, int fr, int fq) const {
        const int row0 = u.pm * 256 + wr * 64 + fr, col0 = u.pn * 256 + wc * 32 + 8 * fq;
        f32x4 ps[2][2];
#pragma unroll
        for (int bj = 0; bj < 2; ++bj)
#pragma unroll
            for (int n = 0; n < 2; ++n) ps[bj][n] = *(const f32x4*)(pool_scale + col0 + bj * 128 + 4 * n);
#pragma unroll
        for (int ai = 0; ai < 2; ++ai)
#pragma unroll
            for (int m = 0; m < 4; ++m) { const size_t off = (size_t)(row0 + ai * 128 + m * 16) * DM + col0;
#pragma unroll
                for (int bj = 0; bj < 2; ++bj) { const v4u gq = *(const v4u*)(GA + off + bj * 128);
                    const f32x4 v0 = acc[ai][bj][m][0] * ps[bj][0], v1 = acc[ai][bj][m][1] * ps[bj][1];
                    v4u w; w.x = pk2(v0[0] * bflo(gq.x), v0[1] * bfhi(gq.x)); w.y = pk2(v0[2] * bflo(gq.y), v0[3] * bfhi(gq.y));
                    w.z = pk2(v1[0] * bflo(gq.z), v1[1] * bfhi(gq.z)); w.w = pk2(v1[2] * bflo(gq.w), v1[3] * bfhi(gq.w));
                    *(v4u*)(YA + off + bj * 128) = w; } }
    }
};
struct EpiRes {
    static constexpr bool PERM = false;
    const float* x; float* x1; const float* ada; const float* b_ada;
    __device__ __forceinline__ void operator()(const f32x4 (&acc)[2][2][4][2], const pg8::Unit& u, int wr, int wc, int fr, int fq) const {
        const int row0 = u.pm * 256 + wr * 64 + fr, col0 = u.pn * 256 + wc * 32 + 4 * fq, b = u.pm >> 3;
        f32x4 gv[2][2];
#pragma unroll
        for (int bj = 0; bj < 2; ++bj)
#pragma unroll
            for (int n = 0; n < 2; ++n) { const int c = 2 * DM + col0 + bj * 128 + n * 16; gv[bj][n] = *(const f32x4*)(ada + (size_t)b * NADA + c) + 1.0f; }
#pragma unroll
        for (int ai = 0; ai < 2; ++ai)
#pragma unroll
            for (int m = 0; m < 4; ++m) { const size_t off = (size_t)(row0 + ai * 128 + m * 16) * DM + col0;
#pragma unroll
                for (int bj = 0; bj < 2; ++bj)
#pragma unroll
                    for (int n = 0; n < 2; ++n) { const f32x4 xv = *(const f32x4*)(x + off + bj * 128 + n * 16); *(f32x4*)(x1 + off + bj * 128 + n * 16) = xv + gv[bj][n] * acc[ai][bj][m][n]; }
                asm volatile("" ::: "memory"); }
    }
};
struct EpiBf16 {
    static constexpr bool PERM = true;
    bf16* O; int ldc;
    __device__ __forceinline__ void operator()(const f32x4 (&acc)[2][2][4][2], const pg8::Unit& u, int wr, int wc, int fr, int fq) const {
        const int row0 = u.pm * 256 + wr * 64 + fr, col0 = u.pn * 256 + wc * 32 + 8 * fq;
#pragma unroll
        for (int ai = 0; ai < 2; ++ai)
#pragma unroll
            for (int m = 0; m < 4; ++m) { bf16* rowp = O + (size_t)(row0 + ai * 128 + m * 16) * ldc + col0;
#pragma unroll
                for (int bj = 0; bj < 2; ++bj) { const f32x4 v0 = acc[ai][bj][m][0], v1 = acc[ai][bj][m][1];
                    v4u w; w.x = pk2(v0[0], v0[1]); w.y = pk2(v0[2], v0[3]); w.z = pk2(v1[0], v1[1]); w.w = pk2(v1[2], v1[3]);
                    *(v4u*)(rowp + bj * 128) = w; } }
    }
};

__device__ __forceinline__ void transpose_item(const float* W, int K, int N, bf16* WT, int ldt, int k0, int n0, int drow0, LAS float* scr, int lane) {
#pragma unroll 8
    for (int i = 0; i < 32; ++i) { const int kk = 2 * i + (lane >> 5); scr[kk * 33 + (lane & 31)] = W[(size_t)(k0 + kk) * N + n0 + (lane & 31)]; }
    LDS_WAIT(); asm volatile("" ::: "memory");
    const int c = lane & 7;
#pragma unroll
    for (int j = 0; j < 4; ++j) { const int n = (lane >> 3) + 8 * j; const LAS float* s = scr + (8 * c) * 33 + n;
        v4u o; o.x = pk2(s[0 * 33], s[1 * 33]); o.y = pk2(s[2 * 33], s[3 * 33]); o.z = pk2(s[4 * 33], s[5 * 33]); o.w = pk2(s[6 * 33], s[7 * 33]);
        *(GAS v4u*)(WT + (size_t)(drow0 + n) * ldt + k0 + 8 * c) = o; }
    LDS_WAIT(); asm volatile("" ::: "memory");
}
__device__ __forceinline__ int win_dst_row(int col) {
    if (col < 7168) return col;
    if (col < 9216) { const int r = col - 7168; return 9216 + (r >> 7) * 256 + (r & 127); }
    if (col < 11264) return 7168 + (col - 9216);
    { const int r = col - 11264; return 9216 + (r >> 7) * 256 + 128 + (r & 127); }
}
__device__ __forceinline__ void cvt_bf16_stream(const float* src, bf16* dst, size_t n, size_t gid, size_t gstride) {
    for (size_t i = gid * 8; i < n; i += gstride * 8) { const f32x4 a = *(const f32x4*)(src + i), b = *(const f32x4*)(src + i + 4);
        v4u w; w.x = pk2(a[0], a[1]); w.y = pk2(a[2], a[3]); w.z = pk2(b[0], b[1]); w.w = pk2(b[2], b[3]); *(v4u*)(dst + i) = w; }
}
__device__ __forceinline__ void phase_prologue(const Args& A, LAS unsigned char* lds) {
    const int tid = threadIdx.x, lane = tid & 63, wave = __builtin_amdgcn_readfirstlane(tid >> 6), G = gridDim.x;
    unsigned char* ws = A.ws;
    {
        LAS float* sc = (LAS float*)lds;
        LAS float* red = sc + 8 * DM;
        float* ada = (float*)(ws + WS_ADA);
        if ((int)blockIdx.x < NADA / 64) {
            for (int e = tid; e < 8 * DM; e += NTHR) { const float cv = A.c[e]; sc[e] = cv * sigmoidf_(cv); }
            __syncthreads();
        }
        for (int it = blockIdx.x; it < NADA / 64; it += G) {
            const int n = it * 64 + lane, k0 = wave * 256;
            float acc[8];
#pragma unroll
            for (int b = 0; b < 8; ++b) acc[b] = 0.f;
            for (int kk = 0; kk < 256; kk += 4) {
                float w[4];
#pragma unroll
                for (int j = 0; j < 4; ++j) w[j] = A.w_ada[(size_t)(k0 + kk + j) * NADA + n];
#pragma unroll
                for (int b = 0; b < 8; ++b) { const f32x4 s = *(const LAS f32x4*)(sc + b * DM + k0 + kk); acc[b] += s[0] * w[0] + s[1] * w[1] + s[2] * w[2] + s[3] * w[3]; }
            }
#pragma unroll
            for (int b = 0; b < 8; ++b) red[(wave * 8 + b) * 64 + lane] = acc[b];
            __syncthreads();
            { const int b = tid >> 6; float s = A.b_ada[n];
#pragma unroll
              for (int w8 = 0; w8 < 8; ++w8) s += red[(w8 * 8 + b) * 64 + lane];
              ada[b * NADA + n] = s; }
            __syncthreads();
        }
        __syncthreads();
    }
    {
        LAS float* scr = (LAS float*)(lds + wave * 16384);
        const int gw = blockIdx.x * NWAVES + wave, NGW = G * NWAVES;
        constexpr int I_IN = (DM / 64) * (NIN / 32), I_SQ = (DM / 64) * (DM / 32), I_PW = 4 * (256 / 64) * (512 / 32);
        for (int it = gw; it < I_IN + 2 * I_SQ + I_PW; it += NGW) {
            int r = it;
            if (r < I_IN) { const int nb = r % (NIN / 32), kb = r / (NIN / 32); transpose_item(A.w_in, DM, NIN, (bf16*)(ws + WS_WIN), DM, kb * 64, nb * 32, win_dst_row(nb * 32), scr, lane); continue; } r -= I_IN;
            if (r < I_SQ) { const int nb = r % (DM / 32), kb = r / (DM / 32); transpose_item(A.w_out, DM, DM, (bf16*)(ws + WS_WOUT), DM, kb * 64, nb * 32, nb * 32, scr, lane); continue; } r -= I_SQ;
            if (r < I_SQ) { const int nb = r % (DM / 32), kb = r / (DM / 32); transpose_item(A.peer_wq, DM, DM, (bf16*)(ws + WS_WQ), DM, kb * 64, nb * 32, nb * 32, scr, lane); continue; } r -= I_SQ;
            { const int g = r / 64, rr = r % 64, nb = rr % 16, kb = rr / 16;
              transpose_item(A.pool_w + (size_t)g * 256 * 512, 256, 512, (bf16*)(ws + WS_POOLW), 256, kb * 64, nb * 32, g * 512 + nb * 32, scr, lane); }
        }
    }
    {
        const size_t gid = (size_t)blockIdx.x * NTHR + tid, gs = (size_t)G * NTHR;
        cvt_bf16_stream(A.peer_keys, (bf16*)(ws + WS_KEYS), (size_t)8 * 2 * 128 * 128, gid, gs);
        cvt_bf16_stream(A.peer_u, (bf16*)(ws + WS_U), (size_t)T * DM, gid, gs);
        cvt_bf16_stream(A.peer_v, (bf16*)(ws + WS_V), (size_t)T * DM, gid, gs);
    }
    if (blockIdx.x == 0) { float* lb = (float*)(ws + WS_LB); for (int k = tid; k < DM; k += NTHR) lb[k] = sigmoidf_(A.lb_logits[k] - A.lb_logits[DM + k]); }
}

__device__ __forceinline__ void phase_modnorm(const float* xin, const float* gain, const float* ada, const float* b_ada, int soff, bf16* outp) {
    const int tid = threadIdx.x, lane = tid & 63, wave = tid >> 6;
    const int gw = blockIdx.x * NWAVES + wave, NGW = gridDim.x * NWAVES;
    for (int m = gw; m < T; m += NGW) {
        const int b = m / SEQ;
        const float* xr = xin + (size_t)m * DM;
        f32x4 v[8]; float s = 0.f;
#pragma unroll
        for (int j = 0; j < 8; ++j) { v[j] = *(const f32x4*)(xr + 4 * lane + 256 * j); s += (v[j][0] * v[j][0] + v[j][1] * v[j][1]) + (v[j][2] * v[j][2] + v[j][3] * v[j][3]); }
        const float rstd = 1.0f / sqrtf(wave_sum(s) * (1.0f / DM) + EPS);
        bf16* orow = outp + (size_t)m * DM;
#pragma unroll
        for (int j = 0; j < 8; ++j) { const int d = 4 * lane + 256 * j;
            const f32x4 gn = *(const f32x4*)(gain + d);
            const f32x4 sh = *(const f32x4*)(ada + (size_t)b * NADA + soff + d);
            const f32x4 sc = *(const f32x4*)(ada + (size_t)b * NADA + soff + DM + d) + 1.0f;
            const f32x4 o = v[j] * rstd * gn * sc + sh;
            v2u w; w.x = pk2(o[0], o[1]); w.y = pk2(o[2], o[3]); *(v2u*)(orow + d) = w; }
    }
}

__device__ __forceinline__ void phase_pool(const bf16* P, bf16* POOLED) {
    const size_t gid = (size_t)blockIdx.x * NTHR + threadIdx.x, gs = (size_t)gridDim.x * NTHR;
    for (size_t it = gid; it < (size_t)T * 128; it += gs) {
        const int t = (int)(it >> 7), ch = (int)(it & 127), g = ch >> 5, w = 2 << g, tl = t & (SEQ - 1), cnt = (tl + 1 < w) ? tl + 1 : w;
        const bf16* p = P + (size_t)t * 1024 + ch * 8;
        float s[8];
#pragma unroll
        for (int e = 0; e < 8; ++e) s[e] = 0.f;
        for (int k = 0; k < cnt; ++k) { const v4u q = *(const v4u*)(p - (size_t)k * 1024);
            s[0] += bflo(q.x); s[1] += bfhi(q.x); s[2] += bflo(q.y); s[3] += bfhi(q.y); s[4] += bflo(q.z); s[5] += bfhi(q.z); s[6] += bflo(q.w); s[7] += bfhi(q.w); }
        const v4u q0 = *(const v4u*)p; const float inv = 1.0f / (float)cnt;
        v4u o; o.x = pk2(s[0] * inv - bflo(q0.x), s[1] * inv - bfhi(q0.x)); o.y = pk2(s[2] * inv - bflo(q0.y), s[3] * inv - bfhi(q0.y));
        o.z = pk2(s[4] * inv - bflo(q0.z), s[5] * inv - bfhi(q0.z)); o.w = pk2(s[6] * inv - bflo(q0.w), s[7] * inv - bfhi(q0.w));
        *(v4u*)(POOLED + (size_t)t * 1024 + ch * 8) = o;
    }
}

__device__ __forceinline__ void phase_hgrn(const Args& A, LAS unsigned char* lds) {
    unsigned char* ws = A.ws;
    const bf16* Q = (const bf16*)(ws + WS_Q); const unsigned short* LF = (const unsigned short*)(ws + WS_LF); const bf16* I = (const bf16*)(ws + WS_I);
    const bf16* GG = (const bf16*)(ws + WS_GG); const bf16* YA = (const bf16*)(ws + WS_YA); bf16* MG = (bf16*)(ws + WS_MERGED);
    LAS float* sF = (LAS float*)lds; LAS float* sK = sF + 4096; LAS float* sQ = sK + 4096; LAS float* sI = sQ + 4096; LAS float* sO = sI + 4096;
    const int tid = threadIdx.x, v = tid & 127, kg = tid >> 7;
    for (int item = blockIdx.x; item < NBATCH * 16; item += gridDim.x) {
        const int b = item >> 4, h = item & 15;
        float S[32];
#pragma unroll
        for (int j = 0; j < 32; ++j) S[j] = 0.f;
        for (int tb = 0; tb < SEQ; tb += 32) {
            __syncthreads();
            for (int e = tid; e < 32 * 128; e += NTHR) { const int tt = e >> 7, c = e & 127; const size_t g = (size_t)(b * SEQ + tb + tt) * DM + h * 128 + c;
                const float f = __expf(h2f(LF[g])); sF[e] = f; sK[e] = 1.0f - f; sQ[e] = bf2f(Q[g]); sI[e] = bf2f(I[g]); }
            __syncthreads();
            for (int tt = 0; tt < 32; ++tt) {
                const float iv = sI[tt * 128 + v]; float part = 0.f;
                const LAS float* pf = sF + tt * 128 + kg * 32; const LAS float* pk = sK + tt * 128 + kg * 32; const LAS float* pq = sQ + tt * 128 + kg * 32;
#pragma unroll
                for (int j4 = 0; j4 < 8; ++j4) { const f32x4 f4 = *(const LAS f32x4*)(pf + 4 * j4), k4 = *(const LAS f32x4*)(pk + 4 * j4), q4 = *(const LAS f32x4*)(pq + 4 * j4);
#pragma unroll
                    for (int e = 0; e < 4; ++e) { S[4 * j4 + e] = f4[e] * S[4 * j4 + e] + k4[e] * iv; part += S[4 * j4 + e] * q4[e]; } }
                sO[(tt * 4 + kg) * 128 + v] = part;
            }
            __syncthreads();
            {
                const int tt = tid >> 4, l16 = tid & 15;
                float o[8]; float ssq = 0.f;
#pragma unroll
                for (int e = 0; e < 8; ++e) { o[e] = 0.f; }
#pragma unroll
                for (int k4 = 0; k4 < 4; ++k4) { const f32x4 a = *(const LAS f32x4*)(sO + (tt * 4 + k4) * 128 + 8 * l16), c = *(const LAS f32x4*)(sO + (tt * 4 + k4) * 128 + 8 * l16 + 4);
                    o[0] += a[0]; o[1] += a[1]; o[2] += a[2]; o[3] += a[3]; o[4] += c[0]; o[5] += c[1]; o[6] += c[2]; o[7] += c[3]; }
#pragma unroll
                for (int e = 0; e < 8; ++e) ssq += o[e] * o[e];
                ssq += __shfl_xor(ssq, 1); ssq += __shfl_xor(ssq, 2); ssq += __shfl_xor(ssq, 4); ssq += __shfl_xor(ssq, 8);
                const float rstd = 1.0f / sqrtf(ssq * (1.0f / 128.0f) + EPS);
                const int col = h * 128 + 8 * l16; const size_t g = (size_t)(b * SEQ + tb + tt) * DM + col;
                const f32x4 n0 = *(const f32x4*)(A.hg_norm + col), n1 = *(const f32x4*)(A.hg_norm + col + 4);
                const v4u gg = *(const v4u*)(GG + g), ya = *(const v4u*)(YA + g);
                v4u w;
                w.x = pk2(bflo(ya.x) + bflo(gg.x) * (o[0] * rstd * n0[0]), bfhi(ya.x) + bfhi(gg.x) * (o[1] * rstd * n0[1]));
                w.y = pk2(bflo(ya.y) + bflo(gg.y) * (o[2] * rstd * n0[2]), bfhi(ya.y) + bfhi(gg.y) * (o[3] * rstd * n0[3]));
                w.z = pk2(bflo(ya.z) + bflo(gg.z) * (o[4] * rstd * n1[0]), bfhi(ya.z) + bfhi(gg.z) * (o[5] * rstd * n1[1]));
                w.w = pk2(bflo(ya.w) + bflo(gg.w) * (o[6] * rstd * n1[2]), bfhi(ya.w) + bfhi(gg.w) * (o[7] * rstd * n1[3]));
                *(v4u*)(MG + g) = w;
            }
        }
        __syncthreads();
    }
}

__device__ __forceinline__ unsigned f2ord(float f) { const unsigned u = __builtin_bit_cast(unsigned, f); return u ^ ((u >> 31) ? 0xffffffffu : 0x80000000u); }
__device__ __forceinline__ float ord2f(unsigned o) { const unsigned u = o ^ ((o >> 31) ? 0x80000000u : 0xffffffffu); return __builtin_bit_cast(float, u); }
__device__ __forceinline__ float dot2bf(unsigned a, unsigned b, float c) { return c + bflo(a) * bflo(b) + bfhi(a) * bfhi(b); }
__device__ __forceinline__ void phase_route(const Args& A, LAS unsigned char* lds) {
    unsigned char* ws = A.ws;
    const bf16* QP = (const bf16*)(ws + WS_QP); const bf16* KB = (const bf16*)(ws + WS_KEYS);
    int* EIDX = (int*)(ws + WS_EIDX); float* GATE = (float*)(ws + WS_GATE);
    const int tid = threadIdx.x, p = tid & 1, tl = tid >> 1;
    constexpr int KOFF1 = 32768 + 16;
    for (int item = blockIdx.x; item < 64 * 8; item += gridDim.x) {
        const int tile = item >> 3, h = item & 7, t = tile * 256 + tl;
        __syncthreads();
        for (int e = tid; e < 4096; e += NTHR) { const int pp = e >> 11, r = e & 2047;
            *(LAS v4u*)(lds + pp * KOFF1 + r * 16) = *(const v4u*)(KB + (size_t)(h * 2 + pp) * 16384 + r * 8); }
        __syncthreads();
        unsigned q[64];
        { const v4u* qp = (const v4u*)(QP + (size_t)t * DM + h * 256 + p * 128);
#pragma unroll
          for (int j = 0; j < 16; ++j) { const v4u a = qp[j]; q[4 * j] = a.x; q[4 * j + 1] = a.y; q[4 * j + 2] = a.z; q[4 * j + 3] = a.w; } }
        unsigned top[16];
#pragma unroll
        for (int j = 0; j < 16; ++j) top[j] = 0u;
        const LAS unsigned char* kp = lds + p * KOFF1;
        for (int n = 0; n < 128; ++n) {
            float s0 = 0.f, s1 = 0.f;
#pragma unroll
            for (int j = 0; j < 16; ++j) { const v4u k4 = *(const LAS v4u*)(kp + n * 256 + j * 16);
                s0 = dot2bf(q[4 * j], k4.x, s0); s1 = dot2bf(q[4 * j + 1], k4.y, s1); s0 = dot2bf(q[4 * j + 2], k4.z, s0); s1 = dot2bf(q[4 * j + 3], k4.w, s1); }
            unsigned key = (f2ord(s0 + s1) & ~127u) | (unsigned)n;
#pragma unroll
            for (int j = 0; j < 16; ++j) { const unsigned hi = top[j] > key ? top[j] : key, lo = top[j] > key ? key : top[j]; top[j] = hi; key = lo; }
        }
        unsigned oth[16];
#pragma unroll
        for (int j = 0; j < 16; ++j) oth[j] = __shfl_xor(top[j], 1);
        float v0[16], v1[16]; int n0[16], n1[16];
#pragma unroll
        for (int j = 0; j < 16; ++j) { const unsigned a0 = p ? oth[j] : top[j], a1 = p ? top[j] : oth[j];
            v0[j] = ord2f(a0 & ~127u); n0[j] = (int)(a0 & 127u); v1[j] = ord2f(a1 & ~127u); n1[j] = (int)(a1 & 127u); }
        float ts[16]; int te[16];
#pragma unroll
        for (int j = 0; j < 16; ++j) { ts[j] = -3.0e38f; te[j] = 0; }
#pragma unroll
        for (int i = 0; i < 16; ++i)
#pragma unroll
            for (int j = 0; j < 16; ++j) if ((i + 1) * (j + 1) <= 16) {
                float s = v0[i] + v1[j]; int e = n0[i] * 128 + n1[j];
#pragma unroll
                for (int k = 0; k < 16; ++k) { const bool gt = s > ts[k]; const float fs = gt ? ts[k] : s; const int fe = gt ? te[k] : e; ts[k] = gt ? s : ts[k]; te[k] = gt ? e : te[k]; s = fs; e = fe; }
            }
        float ex[16], sum = 0.f;
#pragma unroll
        for (int k = 0; k < 16; ++k) { ex[k] = __expf(ts[k] - ts[0]); sum += ex[k]; }
        const float inv = 1.0f / sum;
        int* ep = EIDX + (size_t)t * 128 + h * 16 + 8 * p; float* gp = GATE + (size_t)t * 128 + h * 16 + 8 * p;
#pragma unroll
        for (int k = 0; k < 8; ++k) { const int kk = k + 8; ep[k] = p ? te[kk] : te[k]; gp[k] = (p ? ex[kk] : ex[k]) * inv; }
    }
}

__device__ __forceinline__ void phase_peer(const Args& A, LAS unsigned char* lds) {
    unsigned char* ws = A.ws;
    const bf16* H2 = (const bf16*)(ws + WS_H2); const bf16* UB = (const bf16*)(ws + WS_U); const bf16* VB = (const bf16*)(ws + WS_V);
    const int* EIDX = (const int*)(ws + WS_EIDX); const float* GATE = (const float*)(ws + WS_GATE);
    const float* ada = (const float*)(ws + WS_ADA);
    const int tid = threadIdx.x, lane = tid & 63, wave = tid >> 6, grp = lane >> 4, r = lane & 15;
    LAS float* sd = (LAS float*)lds + wave * 128;
    const int gw = blockIdx.x * NWAVES + wave, NGW = gridDim.x * NWAVES;
    for (int t = gw; t < T; t += NGW) {
        const int b = t / SEQ;
        const int e_lo = EIDX[(size_t)t * 128 + lane], e_hi = EIDX[(size_t)t * 128 + 64 + lane];
        const float g_lo = GATE[(size_t)t * 128 + lane], g_hi = GATE[(size_t)t * 128 + 64 + lane];
        v4u hq[16];
        { const v4u* hp = (const v4u*)(H2 + (size_t)t * DM) + r;
#pragma unroll
          for (int it = 0; it < 16; ++it) hq[it] = hp[16 * it]; }
        for (int qd = 0; qd < 32; ++qd) {
            const int eidx = 4 * qd + grp;
            const int e = __shfl((eidx < 64) ? e_lo : e_hi, eidx & 63);
            const v4u* up = (const v4u*)(UB + (size_t)e * DM) + r;
            float s0 = 0.f, s1 = 0.f;
#pragma unroll
            for (int it = 0; it < 16; ++it) { const v4u u4 = up[16 * it];
                s0 = dot2bf(hq[it].x, u4.x, s0); s1 = dot2bf(hq[it].y, u4.y, s1); s0 = dot2bf(hq[it].z, u4.z, s0); s1 = dot2bf(hq[it].w, u4.w, s1); }
            float s = s0 + s1;
            s += __shfl_xor(s, 1); s += __shfl_xor(s, 2); s += __shfl_xor(s, 4); s += __shfl_xor(s, 8);
            if (r == 0) sd[eidx] = s;
        }
        LDS_WAIT(); asm volatile("" ::: "memory");
        const float d_lo = sd[lane], d_hi = sd[64 + lane];
        LDS_WAIT(); asm volatile("" ::: "memory");
        const float w_lo = g_lo * 0.5f * d_lo * (1.0f + erff(d_lo * 0.70710678f)), w_hi = g_hi * 0.5f * d_hi * (1.0f + erff(d_hi * 0.70710678f));
        float y[32];
#pragma unroll
        for (int j = 0; j < 32; ++j) y[j] = 0.f;
        for (int eidx = 0; eidx < 128; ++eidx) {
            const int e = __builtin_amdgcn_readlane((eidx < 64) ? e_lo : e_hi, eidx & 63);
            const float w = __builtin_bit_cast(float, __builtin_amdgcn_readlane(__builtin_bit_cast(int, (eidx < 64) ? w_lo : w_hi), eidx & 63));
            const v4u* vp = (const v4u*)(VB + (size_t)e * DM) + lane;
#pragma unroll
            for (int j = 0; j < 4; ++j) { const v4u v4 = vp[64 * j];
                y[8 * j + 0] += w * bflo(v4.x); y[8 * j + 1] += w * bfhi(v4.x); y[8 * j + 2] += w * bflo(v4.y); y[8 * j + 3] += w * bfhi(v4.y);
                y[8 * j + 4] += w * bflo(v4.z); y[8 * j + 5] += w * bfhi(v4.z); y[8 * j + 6] += w * bflo(v4.w); y[8 * j + 7] += w * bfhi(v4.w); }
        }
        float* xr = A.out + (size_t)t * DM; float ssq = 0.f;
#pragma unroll
        for (int j = 0; j < 4; ++j) { const int d = 8 * lane + 512 * j;
#pragma unroll
            for (int hh = 0; hh < 2; ++hh) { const f32x4 xv = *(const f32x4*)(xr + d + 4 * hh);
                const f32x4 g2 = *(const f32x4*)(ada + (size_t)b * NADA + 5 * DM + d + 4 * hh) + 1.0f;
#pragma unroll
                for (int e = 0; e < 4; ++e) { const float x2 = xv[e] + g2[e] * y[8 * j + 4 * hh + e]; y[8 * j + 4 * hh + e] = x2; ssq += x2 * x2; } } }
        const float rstd = 1.0f / sqrtf(wave_sum(ssq) * (1.0f / DM) + EPS);
#pragma unroll
        for (int j = 0; j < 4; ++j) { const int d = 8 * lane + 512 * j;
#pragma unroll
            for (int hh = 0; hh < 2; ++hh) { const f32x4 fn = *(const f32x4*)(A.final_norm + d + 4 * hh);
                f32x4 o; o[0] = y[8 * j + 4 * hh] * rstd * fn[0]; o[1] = y[8 * j + 4 * hh + 1] * rstd * fn[1]; o[2] = y[8 * j + 4 * hh + 2] * rstd * fn[2]; o[3] = y[8 * j + 4 * hh + 3] * rstd * fn[3];
                *(f32x4*)(xr + d + 4 * hh) = o; } }
    }
}

__global__ void __launch_bounds__(NTHR, 2) fwd_kernel(Args args) {
    extern __shared__ __attribute__((aligned(16))) unsigned char lds_raw[];
    LAS unsigned char* lds = (LAS unsigned char*)lds_raw;
    volatile LAS unsigned* MISC = (volatile LAS unsigned*)(lds + MISC_OFF);
    const int tid = threadIdx.x, G = gridDim.x;
    unsigned char* ws = args.ws;
    for (int u = tid; u < (LDS_BYTES - LDSCTL_OFF) / 4; u += NTHR) ((LAS unsigned*)(lds + LDSCTL_OFF))[u] = 0u;
    __syncthreads();
    XcdBarrier bar; bar.bar = (unsigned*)(ws + WS_CTL) + CW_BAR; bar.x = 0; bar.st = nullptr;
    if (N_LAUNCHES == 1) bar = xcd_barrier_post((unsigned*)(ws + WS_CTL) + CW_BAR, MISC + 8);
    const int lo = args.ph_lo, hi = args.ph_hi;
#define IN(k) (lo <= (k) && (k) < hi)
#define SEAM(k) do { if (IN(k) && IN((k) + 1)) xcd_barrier(bar); } while (0)
    const float* ada = (const float*)(ws + WS_ADA);

    if (IN(0)) { phase_prologue(args, lds); } SEAM(0);
    if (IN(1)) { phase_modnorm(args.x, args.norm1, ada, args.b_ada, 0, (bf16*)(ws + WS_H1)); } SEAM(1);
    if (IN(2)) {
        pg8::Gemm g{(const bf16*)(ws + WS_H1), (const bf16*)(ws + WS_WIN), T, NIN, DM, DM, DM, 30, 0}; pg8::StaticOrder S; S.init(T, NIN, G, (int)blockIdx.x);
        EpiProj E{(bf16*)(ws + WS_P), (bf16*)(ws + WS_Q), (bf16*)(ws + WS_I), (bf16*)(ws + WS_GA), (bf16*)(ws + WS_GG), (unsigned short*)(ws + WS_LF), (const float*)(ws + WS_LB)};
        pg8::gemm_phase<EpiProj, true>(lds, g, S, E);
    } SEAM(2);
    if (IN(3)) { phase_pool((const bf16*)(ws + WS_P), (bf16*)(ws + WS_POOLED)); } SEAM(3);
    if (IN(4)) {
        pg8::Gemm g{(const bf16*)(ws + WS_POOLED), (const bf16*)(ws + WS_POOLW), T, DM, 256, 1024, 256, 1, 256}; pg8::StaticOrder S; S.init(T, DM, G, (int)blockIdx.x);
        EpiPool E{(bf16*)(ws + WS_YA), (const bf16*)(ws + WS_GA), args.pool_scale};
        pg8::gemm_phase<EpiPool, true>(lds, g, S, E);
    } SEAM(4);
    if (IN(5)) { phase_hgrn(args, lds); } SEAM(5);
    if (IN(6)) {
        pg8::Gemm g{(const bf16*)(ws + WS_MERGED), (const bf16*)(ws + WS_WOUT), T, DM, DM, DM, DM, 30, 0}; pg8::StaticOrder S; S.init(T, DM, G, (int)blockIdx.x);
        EpiRes E{args.x, args.out, ada, args.b_ada};
        pg8::gemm_phase<EpiRes, true>(lds, g, S, E);
    } SEAM(6);
    if (IN(7)) { phase_modnorm(args.out, args.norm2, ada, args.b_ada, 3 * DM, (bf16*)(ws + WS_H2)); } SEAM(7);
    if (IN(8)) {
        pg8::Gemm g{(const bf16*)(ws + WS_H2), (const bf16*)(ws + WS_WQ), T, DM, DM, DM, DM, 30, 0}; pg8::StaticOrder S; S.init(T, DM, G, (int)blockIdx.x);
        EpiBf16 E{(bf16*)(ws + WS_QP), DM};
        pg8::gemm_phase<EpiBf16, true>(lds, g, S, E);
    } SEAM(8);
    if (IN(9)) { phase_route(args, lds); } SEAM(9);
    if (IN(10)) { phase_peer(args, lds); }
#undef IN
#undef SEAM
}

extern "C" void kernel_launch(void* const* d_in, const int* in_sizes, int n_in, void* d_out, int out_size, void* d_ws, size_t ws_size, hipStream_t stream) {
    static int grid = 0;
    if (grid == 0) {
        if (n_in != 17 || in_sizes[0] != T * DM || out_size != T * DM || ws_size < WS_END) {
            fprintf(stderr, "kernel_launch: unexpected shapes (n_in %d, in0 %d, out %d, ws %zu < %zu); nothing launched\n", n_in, n_in > 0 ? in_sizes[0] : -1, out_size, ws_size, (size_t)WS_END); grid = -1; return; }
        int dev = 0, cus = 0, per_cu = 0;
        if (hipGetDevice(&dev) != hipSuccess || hipDeviceGetAttribute(&cus, hipDeviceAttributeMultiprocessorCount, dev) != hipSuccess) { fprintf(stderr, "kernel_launch: device query failed\n"); grid = -1; return; }
        if (hipFuncSetAttribute((const void*)fwd_kernel, hipFuncAttributeMaxDynamicSharedMemorySize, LDS_BYTES) != hipSuccess) { fprintf(stderr, "kernel_launch: hipFuncSetAttribute failed\n"); grid = -1; return; }
        if (hipOccupancyMaxActiveBlocksPerMultiprocessor(&per_cu, (const void*)fwd_kernel, NTHR, LDS_BYTES) != hipSuccess || per_cu < 1) { fprintf(stderr, "kernel_launch: occupancy query reports %d blocks per CU\n", per_cu); }
        (void)hipGetLastError();
        grid = cus;
    }
    if (grid < 0) return;
    (void)hipMemsetAsync((char*)d_ws + WS_CTL, 0, CTL_ZERO_BYTES, stream);
    Args a{};
    a.x = (const float*)d_in[0]; a.c = (const float*)d_in[1]; a.w_ada = (const float*)d_in[2]; a.b_ada = (const float*)d_in[3]; a.norm1 = (const float*)d_in[4];
    a.w_in = (const float*)d_in[5]; a.pool_w = (const float*)d_in[6]; a.pool_scale = (const float*)d_in[7]; a.lb_logits = (const float*)d_in[8]; a.hg_norm = (const float*)d_in[9];
    a.w_out = (const float*)d_in[10]; a.norm2 = (const float*)d_in[11]; a.peer_wq = (const float*)d_in[12]; a.peer_keys = (const float*)d_in[13]; a.peer_u = (const float*)d_in[14];
    a.peer_v = (const float*)d_in[15]; a.final_norm = (const float*)d_in[16];
    a.out = (float*)d_out; a.ws = (unsigned char*)d_ws;
    if (N_LAUNCHES == 1) {
        a.ph_lo = 0; a.ph_hi = N_PHASES; a.li = 0;
        hipLaunchKernelGGL(fwd_kernel, dim3(grid), dim3(NTHR), LDS_BYTES, stream, a);
    } else {
        for (int li = 0; li < N_PHASES; ++li) { a.ph_lo = li; a.ph_hi = li + 1; a.li = li; hipLaunchKernelGGL(fwd_kernel, dim3(grid), dim3(NTHR), LDS_BYTES, stream, a); }
    }
    const hipError_t le = hipPeekAtLastError();
    if (le != hipSuccess) fprintf(stderr, "kernel_launch: launch failed: %s\n", hipGetErrorName(le));
}
```

```cpp
#include <hip/hip_runtime.h>
#include <cstdio>
#include <cstdint>

#ifndef MK_N_LAUNCHES
#define MK_N_LAUNCHES 1
#endif

namespace pg8 {
#define PG8_LAS __attribute__((address_space(3)))
typedef unsigned short bf16_t;
typedef short bf16x8 __attribute__((ext_vector_type(8)));
typedef float f32x4 __attribute__((ext_vector_type(4)));
typedef unsigned u32x4 __attribute__((ext_vector_type(4)));
constexpr int BM = 256, BK = 64, HALF = 128, HTB = HALF * BK * 2  , STAGE_BYTES = 8 * HTB, NXCD = 8, WGM = 8;

__host__ __device__ __forceinline__ int lds_byte(int r, int c) { const int st = (r >> 4) * 2 + (c >> 5), rr = r & 15, cc = c & 31, ob = rr * 64 + cc * 2; return st * 1024 + (ob ^ (((ob >> 9) & 1) << 5)); }
__host__ __device__ __forceinline__ void stage_rc(int b, int& R, int& C) { const int st = b / 1024, sb = b % 1024, swz = sb ^ (((sb >> 9) & 1) << 5); R = (st >> 1) * 16 + swz / 64; C = (st & 1) * 32 + (swz % 64) / 2; }
__host__ __device__ __forceinline__ int perm32(int rho) { const int n = rho >> 4, i = rho & 15; return 8 * (i >> 2) + 4 * n + (i & 3); }

struct Unit { int pm, pn; };
struct Gemm { const bf16_t* A; const bf16_t* Bt; int M, N, K, lda, ldb, a_gshift, a_gstride; };

struct StaticOrder {
    int nM, nN, nwg, G, c;
    __host__ __device__ void init(int M, int N, int G_, int c_) { nM = M / BM; nN = N / BM; nwg = nM * nN; G = G_; c = c_; }
    __host__ __device__ bool next(int i, Unit& u) const {
        const long L = (long)i * G + c; if (L >= nwg) return false;
        int wgid = (int)L; { const int q = nwg / NXCD, r = nwg % NXCD, xcd = wgid % NXCD, off = wgid / NXCD; wgid = (xcd < r ? xcd * (q + 1) : r * (q + 1) + (xcd - r) * q) + off; }
        const int nig = WGM * nN, gid = wgid / nig, fm = gid * WGM, gsz = (nM - fm) < WGM ? (nM - fm) : WGM;
        u.pm = fm + ((wgid % nig) % gsz); u.pn = (wgid % nig) / gsz; return true;
    }
};

__device__ __forceinline__ unsigned cvt_pk_bf16(float lo, float hi) { unsigned r; asm volatile("v_cvt_pk_bf16_f32 %0, %1, %2" : "=v"(r) : "v"(lo), "v"(hi)); return r; }

template <class Epi, bool ALIGN_EPI>
__device__ __forceinline__ void gemm_phase(PG8_LAS unsigned char* lds, const Gemm g, const StaticOrder& S, const Epi& E) {
    const int tid = threadIdx.x, wid = __builtin_amdgcn_readfirstlane(tid >> 6), lane = tid & 63, wr = wid >> 2, wc = wid & 3, fr = lane & 15, fq = lane >> 4;
    const int K = g.K, nt = K / BK;
    unsigned voffA[2], voffB[2];
#pragma unroll
    for (int i = 0; i < 2; ++i) { int R, C; stage_rc(tid * 16 + i * 8192, R, C); const int Rb = Epi::PERM ? ((R & ~31) + perm32(R & 31)) : R;
        voffA[i] = (unsigned)(R * g.lda + C) * 2u; voffB[i] = (unsigned)(Rb * g.ldb + C) * 2u; }
    const size_t kstep = (size_t)(BK * 2);
    const size_t hstepA = (size_t)HALF * g.lda * 2, hstepB = (size_t)HALF * g.ldb * 2;
    const size_t tstepA = 2 * hstepA, tstepB = 2 * hstepB;
    const unsigned ldsw = (unsigned)wid * 1024u;
    const int aoff = lds_byte(wr * 64 + fr, fq * 8), boff = lds_byte(wc * 32 + fr, fq * 8);
#define PG8_SA(b, h) (((b) * 2 + (h)) * HTB)
#define PG8_SB(b, h) ((4 + (b) * 2 + (h)) * HTB)
#define PG8_STAGE(bufoff, gbase, voff) do { _Pragma("unroll") for (int _i = 0; _i < 2; ++_i) \
        __builtin_amdgcn_global_load_lds((const unsigned*)((const char*)(gbase) + (voff)[_i]), (PG8_LAS unsigned*)(lds + (bufoff) + ldsw + _i * 8192), 16, 0, 0); } while (0)
#define PG8_LDA(dst, b, h) do { _Pragma("unroll") for (int m = 0; m < 4; ++m) _Pragma("unroll") for (int k = 0; k < 2; ++k) dst[m][k] = *(const PG8_LAS bf16x8*)(lds + PG8_SA(b, h) + aoff + m * 2048 + k * 1024); } while (0)
#define PG8_LDB(dst, b, h) do { _Pragma("unroll") for (int n = 0; n < 2; ++n) _Pragma("unroll") for (int k = 0; k < 2; ++k) dst[n][k] = *(const PG8_LAS bf16x8*)(lds + PG8_SB(b, h) + boff + n * 2048 + k * 1024); } while (0)
#define PG8_MMA(ai, bj, At, Bt) do { __builtin_amdgcn_s_setprio(1); _Pragma("unroll") for (int m = 0; m < 4; ++m) _Pragma("unroll") for (int n = 0; n < 2; ++n) _Pragma("unroll") for (int k = 0; k < 2; ++k) \
        acc[ai][bj][m][n] = __builtin_amdgcn_mfma_f32_16x16x32_bf16(Bt[n][k], At[m][k], acc[ai][bj][m][n], 0, 0, 0); __builtin_amdgcn_s_setprio(0); } while (0)
#define PG8_WAIT_V(n) asm volatile("s_waitcnt vmcnt(" #n ")" ::: "memory")
#define PG8_WAIT_L(n) asm volatile("s_waitcnt lgkmcnt(" #n ")" ::: "memory")
#define PG8_BAR __builtin_amdgcn_s_barrier()
#define PG8_SCHED __builtin_amdgcn_sched_barrier(0)
#define PG8_UA(u) ((const char*)g.A + (size_t)(u).pm * tstepA + (size_t)(((u).pn >> g.a_gshift) * g.a_gstride) * 2)
#define PG8_UB(u) ((const char*)g.Bt + (size_t)(u).pn * tstepB)
    Unit cur, nxt; int ui = 0;
    if (!S.next(0, cur)) return;
    f32x4 acc[2][2][4][2];
#pragma unroll
    for (int a = 0; a < 2; ++a)
#pragma unroll
        for (int b = 0; b < 2; ++b)
#pragma unroll
            for (int m = 0; m < 4; ++m)
#pragma unroll
                for (int n = 0; n < 2; ++n) acc[a][b][m][n] = (f32x4){0.f, 0.f, 0.f, 0.f};
    bf16x8 At[4][2], B0[2][2], B1[2][2];
    const char* cA = PG8_UA(cur); const char* cB = PG8_UB(cur);
    PG8_STAGE(PG8_SB(0, 0), cB, voffB); PG8_STAGE(PG8_SB(0, 1), cB + hstepB, voffB); PG8_STAGE(PG8_SA(0, 0), cA, voffA); PG8_STAGE(PG8_SA(0, 1), cA + hstepA, voffA);
    if (wr == 1) PG8_BAR;
    PG8_WAIT_V(2); PG8_BAR;
    PG8_STAGE(PG8_SB(1, 0), cB + kstep, voffB); PG8_STAGE(PG8_SA(1, 0), cA + kstep, voffA); PG8_STAGE(PG8_SB(1, 1), cB + hstepB + kstep, voffB);
    PG8_WAIT_V(6); PG8_BAR;
    for (;;) {
        const bool has_next = S.next(ui + 1, nxt);
        const char* nA = has_next ? PG8_UA(nxt) : cA; const char* nB = has_next ? PG8_UB(nxt) : cB;
        for (int t = 0; t < nt; t += 2) {
            const bool last = (t == nt - 2);
            const char* a1 = cA + (size_t)(t + 1) * kstep;
            const char* a2 = last ? nA : cA + (size_t)(t + 2) * kstep; const char* b2 = last ? nB : cB + (size_t)(t + 2) * kstep;
            const char* a3 = a2 + kstep; const char* b3 = b2 + kstep;
            PG8_LDB(B0, 0, 0); PG8_LDB(B1, 0, 1); PG8_SCHED; PG8_LDA(At, 0, 0); PG8_STAGE(PG8_SA(1, 1), a1 + hstepA, voffA);
            PG8_WAIT_V(8); PG8_WAIT_L(0); PG8_BAR; PG8_MMA(0, 0, At, B0); PG8_MMA(0, 1, At, B1); PG8_BAR; PG8_SCHED;
            PG8_LDA(At, 0, 1); PG8_STAGE(PG8_SB(0, 0), b2, voffB); PG8_STAGE(PG8_SB(0, 1), b2 + hstepB, voffB); PG8_STAGE(PG8_SA(0, 0), a2, voffA);
            PG8_WAIT_V(8); PG8_WAIT_L(0); PG8_BAR; PG8_MMA(1, 0, At, B0); PG8_MMA(1, 1, At, B1); PG8_BAR; PG8_SCHED;
            PG8_LDB(B0, 1, 0); PG8_LDB(B1, 1, 1); PG8_SCHED; PG8_LDA(At, 1, 0); PG8_STAGE(PG8_SA(0, 1), a2 + hstepA, voffA);
            PG8_WAIT_V(8); PG8_WAIT_L(0); PG8_BAR; PG8_MMA(0, 0, At, B0); PG8_MMA(0, 1, At, B1); PG8_BAR; PG8_SCHED;
            PG8_LDA(At, 1, 1); PG8_STAGE(PG8_SB(1, 0), b3, voffB); PG8_STAGE(PG8_SB(1, 1), b3 + hstepB, voffB); PG8_STAGE(PG8_SA(1, 0), a3, voffA);
            PG8_WAIT_V(8); PG8_WAIT_L(0); PG8_BAR; PG8_MMA(1, 0, At, B0); PG8_MMA(1, 1, At, B1); PG8_BAR; PG8_SCHED;
        }
        if constexpr (ALIGN_EPI) { if (wr == 0) PG8_BAR; }
        E(acc, cur, wr, wc, fr, fq);
        if (!has_next) break;
#pragma unroll
        for (int a = 0; a < 2; ++a)
#pragma unroll
            for (int b = 0; b < 2; ++b)
#pragma unroll
                for (int m = 0; m < 4; ++m)
#pragma unroll
                    for (int n = 0; n < 2; ++n) acc[a][b][m][n] = (f32x4){0.f, 0.f, 0.f, 0.f};
        cur = nxt; cA = nA; cB = nB; ++ui;
        if constexpr (ALIGN_EPI) { if (wr == 1) PG8_BAR; }
    }
    PG8_WAIT_V(0);
    if constexpr (!ALIGN_EPI) { if (wr == 0) PG8_BAR; }
    PG8_BAR;
#undef PG8_SA
#undef PG8_SB
#undef PG8_STAGE
#undef PG8_LDA
#undef PG8_LDB
#undef PG8_MMA
#undef PG8_WAIT_V
#undef PG8_WAIT_L
#undef PG8_BAR
#undef PG8_SCHED
#undef PG8_UA
#undef PG8_UB
}
}

constexpr int NWAVES = 8, NTHR = 512;
constexpr int T = 16384, DM = 2048, SEQ = 2048, NBATCH = 8, NIN = 13312, NADA = 12288;
constexpr int N_PHASES = 11;
constexpr int N_LAUNCHES = MK_N_LAUNCHES;
constexpr float EPS = 1e-6f;

constexpr size_t MiB = 1u << 20;
constexpr size_t WS_CTL = 0, CTL_ZERO_BYTES = 1 * MiB;
constexpr size_t WS_ADA = 512 * 1024;
constexpr size_t WS_WOUT = 1 * MiB, WS_WQ = 9 * MiB, WS_POOLW = 17 * MiB, WS_KEYS = 18 * MiB, WS_LB = 19 * MiB;
constexpr size_t WS_WIN = 20 * MiB, WS_H1 = 72 * MiB, WS_P = 136 * MiB, WS_GA = 168 * MiB, WS_Q = 232 * MiB, WS_LF = 296 * MiB, WS_I = 360 * MiB, WS_GG = 424 * MiB;
constexpr size_t WS_U = 488 * MiB, WS_V = 552 * MiB, WS_END = 616 * MiB;
constexpr size_t WS_POOLED = 20 * MiB, WS_YA = 72 * MiB, WS_MERGED = 136 * MiB, WS_H2 = 232 * MiB, WS_QP = 296 * MiB, WS_EIDX = 360 * MiB, WS_GATE = 368 * MiB;
constexpr size_t WS_SU = WS_LB + 64 * 1024, WS_SV = WS_LB + 128 * 1024;
constexpr size_t WS_U8 = WS_U, WS_V8 = WS_U + 32 * MiB;
constexpr int CW_BAR = 4096;

constexpr int RING_BYTES = 131072;
constexpr int LDSCTL_OFF = RING_BYTES, MISC_OFF = LDSCTL_OFF + 320;
constexpr int LDS_BYTES = 147456;

#define GAS __attribute__((address_space(1)))
#define LAS __attribute__((address_space(3)))
typedef unsigned short bf16;
typedef unsigned v4u __attribute__((ext_vector_type(4)));
typedef unsigned v2u __attribute__((ext_vector_type(2)));
typedef float f32x4 __attribute__((ext_vector_type(4)));
typedef GAS unsigned gu32;
#define RLX_AGENT __ATOMIC_RELAXED, __HIP_MEMORY_SCOPE_AGENT
#define LDS_WAIT() asm volatile("s_waitcnt lgkmcnt(0)" ::: "memory")
__device__ __forceinline__ unsigned f2bf(float f) { unsigned u = __builtin_bit_cast(unsigned, f); return (u + 0x7fffu + ((u >> 16) & 1u)) >> 16; }
__device__ __forceinline__ unsigned pk2(float lo, float hi) { return pg8::cvt_pk_bf16(lo, hi); }
__device__ __forceinline__ float bflo(unsigned w) { return __builtin_bit_cast(float, w << 16); }
__device__ __forceinline__ float bfhi(unsigned w) { return __builtin_bit_cast(float, w & 0xffff0000u); }
__device__ __forceinline__ float bf2f(bf16 b) { return __builtin_bit_cast(float, ((unsigned)b) << 16); }
__device__ __forceinline__ unsigned pkh2(float a, float b) { const _Float16 ha = (_Float16)a, hb = (_Float16)b; return (unsigned)__builtin_bit_cast(unsigned short, ha) | ((unsigned)__builtin_bit_cast(unsigned short, hb) << 16); }
__device__ __forceinline__ float h2f(unsigned short h) { return (float)__builtin_bit_cast(_Float16, h); }
__device__ __forceinline__ float sigmoidf_(float z) { return 1.0f / (1.0f + __expf(-z)); }
__device__ __forceinline__ float wave_sum(float v) {
#pragma unroll
    for (int o = 1; o < 64; o <<= 1) v += __shfl_xor(v, o);
    return v;
}

#define XB_TMO      128
#define XB_XCNT(j)  (256  + 64 * (j))
#define XB_XSUB(j)  (1280 + 64 * (j))
#define XB_XGEN(j)  (2304 + 64 * (j))
#define XB_TOP      3328
#define XB_TOPGEN   3392
#define XCD_BAR_WORDS 3456
#define XB_SPIN_CAP (1u << 18)
__device__ __forceinline__ unsigned xb_ld(unsigned* p)              { return __hip_atomic_load(p, __ATOMIC_RELAXED, __HIP_MEMORY_SCOPE_AGENT); }
__device__ __forceinline__ unsigned xb_add(unsigned* p, unsigned v) { return __hip_atomic_fetch_add(p, v, __ATOMIC_RELAXED, __HIP_MEMORY_SCOPE_AGENT); }
__device__ __forceinline__ unsigned xb_xcc_id() { return (unsigned)__builtin_amdgcn_s_getreg((3 << 11) | 20) & 0xFu; }
#define XB_SPIN(cond, bar) do { unsigned _sp = 0; while (cond) { __builtin_amdgcn_s_sleep(1); \
    if ((++_sp & 255u) == 0u) { if (xb_ld(&(bar)[XB_TMO])) break; if (_sp > XB_SPIN_CAP) { atomicAdd(&(bar)[XB_TMO], 1u); break; } } } } while (0)
struct XcdBarrier { unsigned* bar; unsigned x; volatile LAS unsigned* st; };
__device__ __forceinline__ XcdBarrier xcd_barrier_post(unsigned* bar, volatile LAS unsigned* st) {
    XcdBarrier b; b.bar = bar; b.x = xb_xcc_id(); b.st = st;
    if (threadIdx.x == 0) (void)xb_add(&bar[XB_XCNT(b.x)], 1u);
    return b;
}
__device__ __forceinline__ void xcd_barrier_complete(unsigned* bar, unsigned x, unsigned& nloc, unsigned& nx) {
    const unsigned G = gridDim.x * gridDim.y * gridDim.z;
    unsigned sum, cnt, mine, sp = 0u;
    for (;;) {
        sum = 0u; cnt = 0u; mine = 0u;
#pragma unroll
        for (unsigned j = 0; j < 16; ++j) { const unsigned c = xb_ld(&bar[XB_XCNT(j)]); sum += c; cnt += (c > 0u) ? 1u : 0u; mine = (j == x) ? c : mine; }
        if (sum == G) break;
        __builtin_amdgcn_s_sleep(1);
        if ((++sp & 255u) == 0u) { if (xb_ld(&bar[XB_TMO])) break; if (sp > XB_SPIN_CAP) { atomicAdd(&bar[XB_TMO], 1u); break; } }
    }
    nloc = mine > 0u ? mine : 1u; nx = cnt > 0u ? cnt : 1u;
}
__device__ __forceinline__ void xcd_barrier(const XcdBarrier& b) {
    asm volatile("s_waitcnt vmcnt(0)" ::: "memory");
    __syncthreads();
    if (threadIdx.x == 0) {
        unsigned* bar = b.bar;
        __builtin_amdgcn_s_waitcnt(0);
        unsigned nloc = b.st[0], nx = b.st[1];
        if (nloc == 0u) { xcd_barrier_complete(bar, b.x, nloc, nx); b.st[0] = nloc; b.st[1] = nx; }
        const unsigned old = xb_add(&bar[XB_XSUB(b.x)], 1u);
        const unsigned gen = old / nloc;
        if (old + 1u == (gen + 1u) * nloc) {
            __builtin_amdgcn_fence(__ATOMIC_RELEASE, "agent");
            asm volatile("s_waitcnt vmcnt(0)" ::: "memory");
            const unsigned og = xb_add(&bar[XB_TOP], 1u);
            const unsigned tg = og / nx;
            if (og + 1u == (tg + 1u) * nx) xb_add(&bar[XB_TOPGEN], 1u);
            else XB_SPIN(xb_ld(&bar[XB_TOPGEN]) == tg, bar);
            __builtin_amdgcn_fence(__ATOMIC_ACQUIRE, "agent");
            xb_add(&bar[XB_XGEN(b.x)], 1u);
            asm volatile("s_waitcnt vmcnt(0)" ::: "memory");
        } else {
            XB_SPIN(xb_ld(&bar[XB_XGEN(b.x)]) == gen, bar);
            __builtin_amdgcn_fence(__ATOMIC_ACQUIRE, "agent");
            asm volatile("s_waitcnt vmcnt(0)" ::: "memory");
        }
    }
    __syncthreads();
}

struct Args {
    const float *x, *c, *w_ada, *b_ada, *norm1, *w_in, *pool_w, *pool_scale, *lb_logits, *hg_norm, *w_out, *norm2, *peer_wq, *peer_keys, *peer_u, *peer_v, *final_norm;
    float* out; unsigned char* ws; int ph_lo, ph_hi, li, pad;
};

struct EpiProj {
    static constexpr bool PERM = true;
    bf16 *P, *I, *GA, *GG; unsigned* LQ; const float* lb;
    __device__ __forceinline__ void operator()(const f32x4 (&acc)[2][2][4][2], const pg8::Unit& u, int wr, int wc, int fr, int fq) const {
        const int pn = u.pn, row0 = u.pm * 256 + wr * 64 + fr, cw = wc * 32 + 8 * fq;
        if (pn >= 36) {
            bf16* base = GG + (size_t)row0 * DM + (pn - 36) * 128 + cw;
#pragma unroll
            for (int ai = 0; ai < 2; ++ai)
#pragma unroll
                for (int m = 0; m < 4; ++m) {
                    float o[8];
#pragma unroll
                    for (int n = 0; n < 2; ++n)
#pragma unroll
                        for (int e = 0; e < 4; ++e) { const float gv = acc[ai][0][m][n][e], bv = acc[ai][1][m][n][e]; o[n * 4 + e] = gv * sigmoidf_(gv) * sigmoidf_(bv); }
                    v4u w; w.x = pk2(o[0], o[1]); w.y = pk2(o[2], o[3]); w.z = pk2(o[4], o[5]); w.w = pk2(o[6], o[7]);
                    *(v4u*)(base + (size_t)(ai * 128 + m * 16) * DM) = w;
                }
            return;
        }
        if (pn >= 4 && pn < 20) {
            const int cb = (pn - 4) * 128 + cw;
            const f32x4 la = *(const f32x4*)(lb + cb), lc = *(const f32x4*)(lb + cb + 4);
            const float lbv[8] = {la[0], la[1], la[2], la[3], lc[0], lc[1], lc[2], lc[3]};
            unsigned* base = LQ + (size_t)row0 * DM + cb;
#pragma unroll
            for (int ai = 0; ai < 2; ++ai)
#pragma unroll
                for (int m = 0; m < 4; ++m) {
                    unsigned o[8];
#pragma unroll
                    for (int n = 0; n < 2; ++n)
#pragma unroll
                        for (int e = 0; e < 4; ++e) { const float l = lbv[n * 4 + e]; const float lf = __logf(l + (1.0f - l) * sigmoidf_(acc[ai][1][m][n][e]));
                            o[n * 4 + e] = (unsigned)__builtin_bit_cast(unsigned short, (_Float16)lf) | (f2bf(acc[ai][0][m][n][e]) << 16); }
                    unsigned* rp = base + (size_t)(ai * 128 + m * 16) * DM;
                    *(v4u*)rp = (v4u){o[0], o[1], o[2], o[3]}; *(v4u*)(rp + 4) = (v4u){o[4], o[5], o[6], o[7]};
                }
            return;
        }
        bf16* dst; int ldc, cb; bool sig = false;
        if (pn < 4) { dst = P; ldc = 1024; cb = pn * 256; }
        else if (pn < 28) { dst = I; ldc = DM; cb = (pn - 20) * 256; }
        else { dst = GA; ldc = DM; cb = (pn - 28) * 256; sig = true; }
        bf16* base = dst + (size_t)row0 * ldc + cb + cw;
#pragma unroll
        for (int ai = 0; ai < 2; ++ai)
#pragma unroll
            for (int m = 0; m < 4; ++m)
#pragma unroll
                for (int bj = 0; bj < 2; ++bj) {
                    f32x4 v0 = acc[ai][bj][m][0], v1 = acc[ai][bj][m][1];
                    if (sig) {
#pragma unroll
                        for (int e = 0; e < 4; ++e) { v0[e] = sigmoidf_(v0[e]); v1[e] = sigmoidf_(v1[e]); } }
                    v4u w; w.x = pk2(v0[0], v0[1]); w.y = pk2(v0[2], v0[3]); w.z = pk2(v1[0], v1[1]); w.w = pk2(v1[2], v1[3]);
                    *(v4u*)(base + (size_t)(ai * 128 + m * 16) * ldc + bj * 128) = w;
                }
    }
};
struct EpiPool {
    static constexpr bool PERM = true;
    bf16* YA; const bf16* GA; const float* pool_scale;
    __device__ __forceinline__ void operator()(const f32x4 (&acc)[2][2][4][2], const pg8::Unit& u, int wr, int wc, int fr, int fq) const {
        const int row0 = u.pm * 256 + wr * 64 + fr, col0 = u.pn * 256 + wc * 32 + 8 * fq;
        f32x4 ps[2][2];
#pragma unroll
        for (int bj = 0; bj < 2; ++bj)
#pragma unroll
            for (int n = 0; n < 2; ++n) ps[bj][n] = *(const f32x4*)(pool_scale + col0 + bj * 128 + 4 * n);
#pragma unroll
        for (int ai = 0; ai < 2; ++ai)
#pragma unroll
            for (int m = 0; m < 4; ++m) { const size_t off = (size_t)(row0 + ai * 128 + m * 16) * DM + col0;
#pragma unroll
                for (int bj = 0; bj < 2; ++bj) { const v4u gq = *(const v4u*)(GA + off + bj * 128);
                    const f32x4 v0 = acc[ai][bj][m][0] * ps[bj][0], v1 = acc[ai][bj][m][1] * ps[bj][1];
                    v4u w; w.x = pk2(v0[0] * bflo(gq.x), v0[1] * bfhi(gq.x)); w.y = pk2(v0[2] * bflo(gq.y), v0[3] * bfhi(gq.y));
                    w.z = pk2(v1[0] * bflo(gq.z), v1[1] * bfhi(gq.z)); w.w = pk2(v1[2] * bflo(gq.w), v1[3] * bfhi(gq.w));
                    *(v4u*)(YA + off + bj * 128) = w; } }
    }
};
struct EpiRes {
    static constexpr bool PERM = false;
    const float* x; float* x1; const float* ada; const float* b_ada;
    __device__ __forceinline__ void operator()(const f32x4 (&acc)[2][2][4][2], const pg8::Unit& u, int wr, int wc, int fr, int fq) const {
        const int row0 = u.pm * 256 + wr * 64 + fr, col0 = u.pn * 256 + wc * 32 + 4 * fq, b = u.pm >> 3;
        f32x4 gv[2][2];
#pragma unroll
        for (int bj = 0; bj < 2; ++bj)
#pragma unroll
            for (int n = 0; n < 2; ++n) { const int c = 2 * DM + col0 + bj * 128 + n * 16; gv[bj][n] = *(const f32x4*)(ada + (size_t)b * NADA + c) + 1.0f; }
#pragma unroll
        for (int ai = 0; ai < 2; ++ai)
#pragma unroll
            for (int m = 0; m < 4; ++m) { const size_t off = (size_t)(row0 + ai * 128 + m * 16) * DM + col0;
#pragma unroll
                for (int bj = 0; bj < 2; ++bj)
#pragma unroll
                    for (int n = 0; n < 2; ++n) { const f32x4 xv = *(const f32x4*)(x + off + bj * 128 + n * 16); *(f32x4*)(x1 + off + bj * 128 + n * 16) = xv + gv[bj][n] * acc[ai][bj][m][n]; }
                asm volatile("" ::: "memory"); }
    }
};
struct EpiBf16 {
    static constexpr bool PERM = true;
    bf16* O; int ldc;
    __device__ __forceinline__ void operator()(const f32x4 (&acc)[2][2][4][2], const pg8::Unit& u, int wr, int wc, int fr, int fq) const {
        const int row0 = u.pm * 256 + wr * 64 + fr, col0 = u.pn * 256 + wc * 32 + 8 * fq;
#pragma unroll
        for (int ai = 0; ai < 2; ++ai)
#pragma unroll
            for (int m = 0; m < 4; ++m) { bf16* rowp = O + (size_t)(row0 + ai * 128 + m * 16) * ldc + col0;
#pragma unroll
                for (int bj = 0; bj < 2; ++bj) { const f32x4 v0 = acc[ai][bj][m][0], v1 = acc[ai][bj][m][1];
                    v4u w; w.x = pk2(v0[0], v0[1]); w.y = pk2(v0[2], v0[3]); w.z = pk2(v1[0], v1[1]); w.w = pk2(v1[2], v1[3]);
                    *(v4u*)(rowp + bj * 128) = w; } }
    }
};

__device__ __forceinline__ void transpose_item(const float* W, int K, int N, bf16* WT, int ldt, int k0, int n0, int drow0, LAS float* scr, int lane) {
#pragma unroll 8
    for (int i = 0; i < 32; ++i) { const int kk = 2 * i + (lane >> 5); scr[kk * 33 + (lane & 31)] = W[(size_t)(k0 + kk) * N + n0 + (lane & 31)]; }
    LDS_WAIT(); asm volatile("" ::: "memory");
    const int c = lane & 7;
#pragma unroll
    for (int j = 0; j < 4; ++j) { const int n = (lane >> 3) + 8 * j; const LAS float* s = scr + (8 * c) * 33 + n;
        v4u o; o.x = pk2(s[0 * 33], s[1 * 33]); o.y = pk2(s[2 * 33], s[3 * 33]); o.z = pk2(s[4 * 33], s[5 * 33]); o.w = pk2(s[6 * 33], s[7 * 33]);
        *(GAS v4u*)(WT + (size_t)(drow0 + n) * ldt + k0 + 8 * c) = o; }
    LDS_WAIT(); asm volatile("" ::: "memory");
}
__device__ __forceinline__ int win_dst_row(int col) {
    if (col < 1024) return col;
    if (col < 3072) { const int r = col - 1024; return 1024 + (r >> 7) * 256 + (r & 127); }
    if (col < 5120) { const int r = col - 3072; return 1024 + (r >> 7) * 256 + 128 + (r & 127); }
    if (col < 7168) return col;
    if (col < 9216) { const int r = col - 7168; return 9216 + (r >> 7) * 256 + (r & 127); }
    if (col < 11264) return 7168 + (col - 9216);
    { const int r = col - 11264; return 9216 + (r >> 7) * 256 + 128 + (r & 127); }
}
__device__ __forceinline__ void cvt_bf16_stream(const float* src, bf16* dst, size_t n, size_t gid, size_t gstride) {
    for (size_t i = gid * 8; i < n; i += gstride * 8) { const f32x4 a = *(const f32x4*)(src + i), b = *(const f32x4*)(src + i + 4);
        v4u w; w.x = pk2(a[0], a[1]); w.y = pk2(a[2], a[3]); w.z = pk2(b[0], b[1]); w.w = pk2(b[2], b[3]); *(v4u*)(dst + i) = w; }
}
__device__ __forceinline__ void quantize_uv(const Args& A, int gw, int NGW) {
    unsigned char* ws = A.ws; const int lane = threadIdx.x & 63;
    for (int it = gw; it < 2 * T; it += NGW) {
        const int e = it & (T - 1); const bool isv = it >= T;
        const float* src = (isv ? A.peer_v : A.peer_u) + (size_t)e * DM;
        unsigned char* dst = ws + (isv ? WS_V8 : WS_U8) + (size_t)e * DM;
        f32x4 a[8]; float am = 0.f;
#pragma unroll
        for (int j = 0; j < 4; ++j) { a[2 * j] = *(const f32x4*)(src + 8 * lane + 512 * j); a[2 * j + 1] = *(const f32x4*)(src + 8 * lane + 512 * j + 4); }
#pragma unroll
        for (int j = 0; j < 8; ++j) am = fmaxf(am, fmaxf(fmaxf(fabsf(a[j][0]), fabsf(a[j][1])), fmaxf(fabsf(a[j][2]), fabsf(a[j][3]))));
#pragma unroll
        for (int o = 1; o < 64; o <<= 1) am = fmaxf(am, __shfl_xor(am, o));
        const float sc = am > 0.f ? 440.0f / am : 1.0f, inv = am > 0.f ? am * (1.0f / 440.0f) : 1.0f;
#pragma unroll
        for (int j = 0; j < 4; ++j) { v2u w;
            int w0 = __builtin_amdgcn_cvt_pk_fp8_f32(a[2 * j][0] * sc, a[2 * j][1] * sc, 0, false); w0 = __builtin_amdgcn_cvt_pk_fp8_f32(a[2 * j][2] * sc, a[2 * j][3] * sc, w0, true);
            int w1 = __builtin_amdgcn_cvt_pk_fp8_f32(a[2 * j + 1][0] * sc, a[2 * j + 1][1] * sc, 0, false); w1 = __builtin_amdgcn_cvt_pk_fp8_f32(a[2 * j + 1][2] * sc, a[2 * j + 1][3] * sc, w1, true);
            w.x = (unsigned)w0; w.y = (unsigned)w1; *(v2u*)(dst + 8 * lane + 512 * j) = w; }
        if (lane == 0) ((float*)(ws + (isv ? WS_SV : WS_SU)))[e] = inv;
    }
}
__device__ __forceinline__ void phase_prologue(const Args& A, LAS unsigned char* lds) {
    const int tid = threadIdx.x, lane = tid & 63, wave = __builtin_amdgcn_readfirstlane(tid >> 6), G = gridDim.x;
    unsigned char* ws = A.ws;
    {
        LAS float* sc = (LAS float*)lds;
        LAS float* red = sc + 8 * DM;
        float* ada = (float*)(ws + WS_ADA);
        if ((int)blockIdx.x < NADA / 64) {
            for (int e = tid; e < 8 * DM; e += NTHR) { const float cv = A.c[e]; sc[e] = cv * sigmoidf_(cv); }
            __syncthreads();
        }
        for (int it = blockIdx.x; it < NADA / 64; it += G) {
            const int n = it * 64 + lane, k0 = wave * 256;
            float acc[8];
#pragma unroll
            for (int b = 0; b < 8; ++b) acc[b] = 0.f;
            for (int kk = 0; kk < 256; kk += 4) {
                float w[4];
#pragma unroll
                for (int j = 0; j < 4; ++j) w[j] = A.w_ada[(size_t)(k0 + kk + j) * NADA + n];
#pragma unroll
                for (int b = 0; b < 8; ++b) { const f32x4 s = *(const LAS f32x4*)(sc + b * DM + k0 + kk); acc[b] += s[0] * w[0] + s[1] * w[1] + s[2] * w[2] + s[3] * w[3]; }
            }
#pragma unroll
            for (int b = 0; b < 8; ++b) red[(wave * 8 + b) * 64 + lane] = acc[b];
            __syncthreads();
            { const int b = tid >> 6; float s = A.b_ada[n];
#pragma unroll
              for (int w8 = 0; w8 < 8; ++w8) s += red[(w8 * 8 + b) * 64 + lane];
              ada[b * NADA + n] = s; }
            __syncthreads();
        }
        __syncthreads();
    }
    {
        LAS float* scr = (LAS float*)(lds + wave * 16384);
        const int gw = blockIdx.x * NWAVES + wave, NGW = G * NWAVES;
        constexpr int I_IN = (DM / 64) * (NIN / 32), I_SQ = (DM / 64) * (DM / 32), I_PW = 4 * (256 / 64) * (512 / 32);
        for (int it = gw; it < I_IN + 2 * I_SQ + I_PW; it += NGW) {
            int r = it;
            if (r < I_IN) { const int nb = r % (NIN / 32), kb = r / (NIN / 32); transpose_item(A.w_in, DM, NIN, (bf16*)(ws + WS_WIN), DM, kb * 64, nb * 32, win_dst_row(nb * 32), scr, lane); continue; } r -= I_IN;
            if (r < I_SQ) { const int nb = r % (DM / 32), kb = r / (DM / 32); transpose_item(A.w_out, DM, DM, (bf16*)(ws + WS_WOUT), DM, kb * 64, nb * 32, nb * 32, scr, lane); continue; } r -= I_SQ;
            if (r < I_SQ) { const int nb = r % (DM / 32), kb = r / (DM / 32); transpose_item(A.peer_wq, DM, DM, (bf16*)(ws + WS_WQ), DM, kb * 64, nb * 32, nb * 32, scr, lane); continue; } r -= I_SQ;
            { const int g = r / 64, rr = r % 64, nb = rr % 16, kb = rr / 16;
              transpose_item(A.pool_w + (size_t)g * 256 * 512, 256, 512, (bf16*)(ws + WS_POOLW), 256, kb * 64, nb * 32, g * 512 + nb * 32, scr, lane); }
        }
    }
    {
        const size_t gid = (size_t)blockIdx.x * NTHR + tid, gs = (size_t)G * NTHR;
        cvt_bf16_stream(A.peer_keys, (bf16*)(ws + WS_KEYS), (size_t)8 * 2 * 128 * 128, gid, gs);
    }
    if (blockIdx.x == 0) { float* lb = (float*)(ws + WS_LB); for (int k = tid; k < DM; k += NTHR) lb[k] = sigmoidf_(A.lb_logits[k] - A.lb_logits[DM + k]); }
}

__device__ __forceinline__ void phase_modnorm(const float* xin, const float* gain, const float* ada, const float* b_ada, int soff, bf16* outp) {
    const int tid = threadIdx.x, lane = tid & 63, wave = tid >> 6;
    const int gw = blockIdx.x * NWAVES + wave, NGW = gridDim.x * NWAVES;
    for (int m = gw; m < T; m += NGW) {
        const int b = m / SEQ;
        const float* xr = xin + (size_t)m * DM;
        f32x4 v[8]; float s = 0.f;
#pragma unroll
        for (int j = 0; j < 8; ++j) { v[j] = *(const f32x4*)(xr + 4 * lane + 256 * j); s += (v[j][0] * v[j][0] + v[j][1] * v[j][1]) + (v[j][2] * v[j][2] + v[j][3] * v[j][3]); }
        const float rstd = 1.0f / sqrtf(wave_sum(s) * (1.0f / DM) + EPS);
        bf16* orow = outp + (size_t)m * DM;
#pragma unroll
        for (int j = 0; j < 8; ++j) { const int d = 4 * lane + 256 * j;
            const f32x4 gn = *(const f32x4*)(gain + d);
            const f32x4 sh = *(const f32x4*)(ada + (size_t)b * NADA + soff + d);
            const f32x4 sc = *(const f32x4*)(ada + (size_t)b * NADA + soff + DM + d) + 1.0f;
            const f32x4 o = v[j] * rstd * gn * sc + sh;
            v2u w; w.x = pk2(o[0], o[1]); w.y = pk2(o[2], o[3]); *(v2u*)(orow + d) = w; }
    }
}

__device__ __forceinline__ void phase_pool(const bf16* P, bf16* POOLED) {
    const size_t gid = (size_t)blockIdx.x * NTHR + threadIdx.x, gs = (size_t)gridDim.x * NTHR;
    for (size_t it = gid; it < (size_t)T * 128; it += gs) {
        const int t = (int)(it >> 7), ch = (int)(it & 127), g = ch >> 5, w = 2 << g, tl = t & (SEQ - 1), cnt = (tl + 1 < w) ? tl + 1 : w;
        const bf16* p = P + (size_t)t * 1024 + ch * 8;
        float s[8];
#pragma unroll
        for (int e = 0; e < 8; ++e) s[e] = 0.f;
        for (int k = 0; k < cnt; ++k) { const v4u q = *(const v4u*)(p - (size_t)k * 1024);
            s[0] += bflo(q.x); s[1] += bfhi(q.x); s[2] += bflo(q.y); s[3] += bfhi(q.y); s[4] += bflo(q.z); s[5] += bfhi(q.z); s[6] += bflo(q.w); s[7] += bfhi(q.w); }
        const v4u q0 = *(const v4u*)p; const float inv = 1.0f / (float)cnt;
        v4u o; o.x = pk2(s[0] * inv - bflo(q0.x), s[1] * inv - bfhi(q0.x)); o.y = pk2(s[2] * inv - bflo(q0.y), s[3] * inv - bfhi(q0.y));
        o.z = pk2(s[4] * inv - bflo(q0.z), s[5] * inv - bfhi(q0.z)); o.w = pk2(s[6] * inv - bflo(q0.w), s[7] * inv - bfhi(q0.w));
        *(v4u*)(POOLED + (size_t)t * 1024 + ch * 8) = o;
    }
}

constexpr int HG_LD = 144, HG_TILE = 64 * HG_LD * 2;
constexpr int HG_QT = 0, HG_KT = HG_TILE, HG_IL = 2 * HG_TILE, HG_AM = 3 * HG_TILE, HG_AMLD = 72;
constexpr int HG_VEC = HG_AM + 64 * HG_AMLD * 2, HG_PART = HG_VEC + 3 * 128 * 4, HG_OT = HG_PART + 4 * 128 * 4, HG_OTLD = 132, HG_END = HG_OT + 64 * HG_OTLD * 4;
static_assert(HG_END <= RING_BYTES, "hgrn LDS map");
typedef short s16x4 __attribute__((ext_vector_type(4)));
#define HG_BAR() do { asm volatile("s_waitcnt lgkmcnt(0)" ::: "memory"); __builtin_amdgcn_s_barrier(); asm volatile("" ::: "memory"); } while (0)
__device__ __forceinline__ pg8::bf16x8 hg_tr8(const LAS unsigned char* p, int rowbytes4) {
    const s16x4 lo = __builtin_amdgcn_ds_read_tr16_b64_v4i16((s16x4 LAS*)p), hi = __builtin_amdgcn_ds_read_tr16_b64_v4i16((s16x4 LAS*)(p + rowbytes4));
    pg8::bf16x8 o; o[0] = lo[0]; o[1] = lo[1]; o[2] = lo[2]; o[3] = lo[3]; o[4] = hi[0]; o[5] = hi[1]; o[6] = hi[2]; o[7] = hi[3]; return o;
}
__device__ __forceinline__ void hgrn_item(const Args& A, LAS unsigned char* lds, int item) {
    unsigned char* ws = A.ws;
    const unsigned* LQ = (const unsigned*)(ws + WS_Q); const bf16* I = (const bf16*)(ws + WS_I);
    const bf16* GG = (const bf16*)(ws + WS_GG); const bf16* YA = (const bf16*)(ws + WS_YA); bf16* MG = (bf16*)(ws + WS_MERGED);
    const int tid = threadIdx.x, lane = tid & 63, w = __builtin_amdgcn_readfirstlane(tid >> 6), r = lane & 15, g = lane >> 4, q4 = r >> 2, p4 = lane & 3;
    const int ek = tid & 127, etq = tid >> 7, is = tid >> 3, iseg = tid & 7;
    const int b = item >> 4, h = item & 15, colbase = h * 128;
    const size_t row0 = (size_t)b * SEQ;
    LAS bf16* QT = (LAS bf16*)(lds + HG_QT); LAS bf16* KT = (LAS bf16*)(lds + HG_KT); LAS bf16* IL = (LAS bf16*)(lds + HG_IL); LAS bf16* AM = (LAS bf16*)(lds + HG_AM);
    LAS float* VEC = (LAS float*)(lds + HG_VEC); LAS float* PART = (LAS float*)(lds + HG_PART); LAS float* OT = (LAS float*)(lds + HG_OT);
    f32x4 Sacc[8];
#pragma unroll
    for (int m = 0; m < 8; ++m) Sacc[m] = (f32x4){0.f, 0.f, 0.f, 0.f};
    const int orow = tid >> 3, oseg = tid & 7;
    unsigned raw[16]; v4u ir[2];
    const int evo_ = 16 * etq * DM + ek, ivo_ = is * DM + 16 * iseg;
#define HG_LOADRAW(c) do { const size_t _u0 = (row0 + 64 * (c)) * DM + colbase; int evo = evo_, ivo = ivo_; asm volatile("" : "+v"(evo), "+v"(ivo)); \
        _Pragma("unroll") for (int j = 0; j < 16; ++j) { const unsigned* _lp = LQ + _u0 + (size_t)j * DM; raw[j] = _lp[evo]; } \
        const bf16* _ib = I + _u0; const v4u* _ip = (const v4u*)(_ib + ivo); ir[0] = _ip[0]; ir[1] = _ip[1]; } while (0)
    HG_LOADRAW(0);
    for (int c = 0; c < SEQ / 64; ++c) {
        float run = 0.f;
#pragma unroll
        for (int j = 0; j < 16; ++j) run += h2f((unsigned short)(raw[j] & 0xffffu));
        PART[etq * 128 + ek] = run;
        HG_BAR();
        const float p0 = PART[ek], p1 = PART[128 + ek], p2 = PART[256 + ek], p3 = PART[384 + ek];
        const float pre = (etq > 0 ? p0 : 0.f) + (etq > 1 ? p1 : 0.f) + (etq > 2 ? p2 : 0.f), rr = p0 + p1, tot = rr + p2 + p3;
        float cj = pre - rr;
#pragma unroll
        for (int j = 0; j < 16; ++j) {
            const float lfj = h2f((unsigned short)(raw[j] & 0xffffu)); cj += lfj;
            const float x = fminf(fmaxf(cj, -80.f), 80.f), e1 = __expf(x), f = __expf(lfj);
            const float qt = __builtin_bit_cast(float, raw[j] & 0xffff0000u) * e1, kt = (1.0f - f) * __builtin_amdgcn_rcpf(e1);
            QT[(16 * etq + j) * HG_LD + ek] = (bf16)f2bf(qt); KT[(16 * etq + j) * HG_LD + ek] = (bf16)f2bf(kt);
        }
        if (etq == 0) { VEC[ek] = __expf(fmaxf(rr, -80.f)); VEC[128 + ek] = __expf(tot - rr); VEC[256 + ek] = __expf(tot); }
        *(LAS v4u*)(IL + is * HG_LD + 16 * iseg) = ir[0]; *(LAS v4u*)(IL + is * HG_LD + 16 * iseg + 8) = ir[1];
        HG_BAR();
        if (c + 1 < SEQ / 64) HG_LOADRAW(c + 1);
        {
            const int tt = w >> 1;
#pragma unroll
            for (int st2 = 0; st2 < 2; ++st2) {
                const int st = 2 * (w & 1) + st2;
                f32x4 acc = (f32x4){0.f, 0.f, 0.f, 0.f};
                if (st <= tt) {
#pragma unroll
                    for (int ks = 0; ks < 4; ++ks) {
                        const pg8::bf16x8 af = *(const LAS pg8::bf16x8*)(KT + (16 * st + r) * HG_LD + 32 * ks + 8 * g);
                        const pg8::bf16x8 bf = *(const LAS pg8::bf16x8*)(QT + (16 * tt + r) * HG_LD + 32 * ks + 8 * g);
                        acc = __builtin_amdgcn_mfma_f32_16x16x32_bf16(af, bf, acc, 0, 0, 0);
                    }
                    const int t = 16 * tt + r, s0 = 16 * st + 4 * g;
#pragma unroll
                    for (int j = 0; j < 4; ++j) acc[j] = (s0 + j <= t) ? acc[j] : 0.f;
                }
                v2u pk; pk.x = pk2(acc[0], acc[1]); pk.y = pk2(acc[2], acc[3]);
                *(LAS v2u*)(AM + (16 * tt + r) * HG_AMLD + 16 * st + 4 * g) = pk;
            }
        }
        v4u yav[2], ggv[2];
        { int ovo = orow * DM + 16 * oseg; asm volatile("" : "+v"(ovo));
          const size_t gu = (row0 + 64 * c) * DM + colbase; const bf16* _yp = YA + gu; const bf16* _gp = GG + gu;
          yav[0] = *(const v4u*)(_yp + ovo); yav[1] = *(const v4u*)(_yp + ovo + 8); ggv[0] = *(const v4u*)(_gp + ovo); ggv[1] = *(const v4u*)(_gp + ovo + 8); }
        HG_BAR();
        pg8::bf16x8 ifr[2];
#pragma unroll
        for (int ks = 0; ks < 2; ++ks) ifr[ks] = hg_tr8((const LAS unsigned char*)(IL + (32 * ks + 8 * g + q4) * HG_LD + 16 * w + 4 * p4), 4 * HG_LD * 2);
        f32x4 oacc[4];
#pragma unroll
        for (int tt = 0; tt < 4; ++tt) oacc[tt] = (f32x4){0.f, 0.f, 0.f, 0.f};
#pragma unroll
        for (int tt = 0; tt < 4; ++tt)
#pragma unroll
            for (int ks = 0; ks < 2; ++ks) { const pg8::bf16x8 af = *(const LAS pg8::bf16x8*)(AM + (16 * tt + r) * HG_AMLD + 32 * ks + 8 * g);
                oacc[tt] = __builtin_amdgcn_mfma_f32_16x16x32_bf16(af, ifr[ks], oacc[tt], 0, 0, 0); }
#pragma unroll
        for (int ks = 0; ks < 4; ++ks) {
            const f32x4 e0 = *(const LAS f32x4*)(VEC + 32 * ks + 4 * g), e1 = *(const LAS f32x4*)(VEC + 32 * ks + 16 + 4 * g);
            const f32x4 s0 = Sacc[2 * ks] * e0, s1 = Sacc[2 * ks + 1] * e1;
            v4u sb; sb.x = pk2(s0[0], s0[1]); sb.y = pk2(s0[2], s0[3]); sb.z = pk2(s1[0], s1[1]); sb.w = pk2(s1[2], s1[3]);
            const pg8::bf16x8 sfr = __builtin_bit_cast(pg8::bf16x8, sb);
#pragma unroll
            for (int tt = 0; tt < 4; ++tt) {
                const v2u a0 = *(const LAS v2u*)(QT + (16 * tt + r) * HG_LD + 32 * ks + 4 * g), a1 = *(const LAS v2u*)(QT + (16 * tt + r) * HG_LD + 32 * ks + 16 + 4 * g);
                v4u ab; ab.x = a0.x; ab.y = a0.y; ab.z = a1.x; ab.w = a1.y;
                oacc[tt] = __builtin_amdgcn_mfma_f32_16x16x32_bf16(__builtin_bit_cast(pg8::bf16x8, ab), sfr, oacc[tt], 0, 0, 0);
            }
        }
#pragma unroll
        for (int mt = 0; mt < 8; ++mt) {
            f32x4 P = (f32x4){0.f, 0.f, 0.f, 0.f};
#pragma unroll
            for (int ks = 0; ks < 2; ++ks) { const pg8::bf16x8 af = hg_tr8((const LAS unsigned char*)(KT + (32 * ks + 8 * g + q4) * HG_LD + 16 * mt + 4 * p4), 4 * HG_LD * 2);
                P = __builtin_amdgcn_mfma_f32_16x16x32_bf16(af, ifr[ks], P, 0, 0, 0); }
            const f32x4 el4 = *(const LAS f32x4*)(VEC + 128 + 16 * mt + 4 * g), d4 = *(const LAS f32x4*)(VEC + 256 + 16 * mt + 4 * g);
            Sacc[mt] = d4 * Sacc[mt] + el4 * P;
        }
#pragma unroll
        for (int tt = 0; tt < 4; ++tt)
#pragma unroll
            for (int j = 0; j < 4; ++j) OT[(16 * tt + 4 * g + j) * HG_OTLD + 16 * w + r] = oacc[tt][j];
        HG_BAR();
        {
            float o[16]; float ssq = 0.f;
#pragma unroll
            for (int q = 0; q < 4; ++q) { const f32x4 t4 = *(const LAS f32x4*)(OT + orow * HG_OTLD + 16 * oseg + 4 * q); o[4 * q] = t4[0]; o[4 * q + 1] = t4[1]; o[4 * q + 2] = t4[2]; o[4 * q + 3] = t4[3]; }
#pragma unroll
            for (int e = 0; e < 16; ++e) ssq += o[e] * o[e];
            ssq += __shfl_xor(ssq, 1); ssq += __shfl_xor(ssq, 2); ssq += __shfl_xor(ssq, 4);
            const float rstd = 1.0f / sqrtf(ssq * (1.0f / 128.0f) + EPS);
            const float* hn = A.hg_norm + colbase + 16 * oseg;
            bf16* mp = MG + (row0 + 64 * c) * DM + colbase;
            int ovo = orow * DM + 16 * oseg; asm volatile("" : "+v"(ovo));
#pragma unroll
            for (int hh = 0; hh < 2; ++hh) {
                const f32x4 n0 = *(const f32x4*)(hn + 8 * hh), n1 = *(const f32x4*)(hn + 8 * hh + 4);
                const v4u ya = yav[hh], gg = ggv[hh]; v4u wv;
                wv.x = pk2(bflo(ya.x) + bflo(gg.x) * (o[8 * hh + 0] * rstd * n0[0]), bfhi(ya.x) + bfhi(gg.x) * (o[8 * hh + 1] * rstd * n0[1]));
                wv.y = pk2(bflo(ya.y) + bflo(gg.y) * (o[8 * hh + 2] * rstd * n0[2]), bfhi(ya.y) + bfhi(gg.y) * (o[8 * hh + 3] * rstd * n0[3]));
                wv.z = pk2(bflo(ya.z) + bflo(gg.z) * (o[8 * hh + 4] * rstd * n1[0]), bfhi(ya.z) + bfhi(gg.z) * (o[8 * hh + 5] * rstd * n1[1]));
                wv.w = pk2(bflo(ya.w) + bflo(gg.w) * (o[8 * hh + 6] * rstd * n1[2]), bfhi(ya.w) + bfhi(gg.w) * (o[8 * hh + 7] * rstd * n1[3]));
                *(v4u*)(mp + ovo + 8 * hh) = wv;
            }
        }
    }
#undef HG_LOADRAW
    HG_BAR();
}
__device__ __forceinline__ void phase_hgrn_fast(const Args& A, LAS unsigned char* lds) {
    const int G = gridDim.x, wave = threadIdx.x >> 6;
    const bool split = G >= 256;
    if (!split || (int)blockIdx.x < 128) for (int item = blockIdx.x; item < NBATCH * 16; item += (split ? 128 : G)) hgrn_item(A, lds, item);
    if (!split) quantize_uv(A, blockIdx.x * NWAVES + wave, G * NWAVES);
    else if ((int)blockIdx.x >= 128) quantize_uv(A, ((int)blockIdx.x - 128) * NWAVES + wave, (G - 128) * NWAVES);
}

__device__ __forceinline__ unsigned f2ord(float f) { const unsigned u = __builtin_bit_cast(unsigned, f); return u ^ ((u >> 31) ? 0xffffffffu : 0x80000000u); }
__device__ __forceinline__ float ord2f(unsigned o) { const unsigned u = o ^ ((o >> 31) ? 0x80000000u : 0xffffffffu); return __builtin_bit_cast(float, u); }
__device__ __forceinline__ float dot2bf(unsigned a, unsigned b, float c) { return c + bflo(a) * bflo(b) + bfhi(a) * bfhi(b); }
__device__ __forceinline__ void phase_route(const Args& A, LAS unsigned char* lds) {
    unsigned char* ws = A.ws;
    const bf16* QP = (const bf16*)(ws + WS_QP); const bf16* KB = (const bf16*)(ws + WS_KEYS);
    int* EIDX = (int*)(ws + WS_EIDX); float* GATE = (float*)(ws + WS_GATE);
    const int tid = threadIdx.x, p = tid & 1, tl = tid >> 1;
    constexpr int KOFF1 = 32768 + 16;
    for (int item = blockIdx.x; item < 64 * 8; item += gridDim.x) {
        const int tile = item >> 3, h = item & 7, t = tile * 256 + tl;
        __syncthreads();
        for (int e = tid; e < 4096; e += NTHR) { const int pp = e >> 11, r = e & 2047;
            *(LAS v4u*)(lds + pp * KOFF1 + r * 16) = *(const v4u*)(KB + (size_t)(h * 2 + pp) * 16384 + r * 8); }
        __syncthreads();
        unsigned q[64];
        { const v4u* qp = (const v4u*)(QP + (size_t)t * DM + h * 256 + p * 128);
#pragma unroll
          for (int j = 0; j < 16; ++j) { const v4u a = qp[j]; q[4 * j] = a.x; q[4 * j + 1] = a.y; q[4 * j + 2] = a.z; q[4 * j + 3] = a.w; } }
        unsigned top[16];
#pragma unroll
        for (int j = 0; j < 16; ++j) top[j] = 0u;
        const LAS unsigned char* kp = lds + p * KOFF1;
        for (int n = 0; n < 128; ++n) {
            float s0 = 0.f, s1 = 0.f;
#pragma unroll
            for (int j = 0; j < 16; ++j) { const v4u k4 = *(const LAS v4u*)(kp + n * 256 + j * 16);
                s0 = dot2bf(q[4 * j], k4.x, s0); s1 = dot2bf(q[4 * j + 1], k4.y, s1); s0 = dot2bf(q[4 * j + 2], k4.z, s0); s1 = dot2bf(q[4 * j + 3], k4.w, s1); }
            unsigned key = (f2ord(s0 + s1) & ~127u) | (unsigned)n;
#pragma unroll
            for (int j = 0; j < 16; ++j) { const unsigned hi = top[j] > key ? top[j] : key, lo = top[j] > key ? key : top[j]; top[j] = hi; key = lo; }
        }
        unsigned oth[16];
#pragma unroll
        for (int j = 0; j < 16; ++j) oth[j] = __shfl_xor(top[j], 1);
        float v0[16], v1[16]; int n0[16], n1[16];
#pragma unroll
        for (int j = 0; j < 16; ++j) { const unsigned a0 = p ? oth[j] : top[j], a1 = p ? top[j] : oth[j];
            v0[j] = ord2f(a0 & ~127u); n0[j] = (int)(a0 & 127u); v1[j] = ord2f(a1 & ~127u); n1[j] = (int)(a1 & 127u); }
        float ts[16]; int te[16];
#pragma unroll
        for (int j = 0; j < 16; ++j) { ts[j] = -3.0e38f; te[j] = 0; }
#pragma unroll
        for (int i = 0; i < 16; ++i)
#pragma unroll
            for (int j = 0; j < 16; ++j) if ((i + 1) * (j + 1) <= 16) {
                float s = v0[i] + v1[j]; int e = n0[i] * 128 + n1[j];
#pragma unroll
                for (int k = 0; k < 16; ++k) { const bool gt = s > ts[k]; const float fs = gt ? ts[k] : s; const int fe = gt ? te[k] : e; ts[k] = gt ? s : ts[k]; te[k] = gt ? e : te[k]; s = fs; e = fe; }
            }
        float ex[16], sum = 0.f;
#pragma unroll
        for (int k = 0; k < 16; ++k) { ex[k] = __expf(ts[k] - ts[0]); sum += ex[k]; }
        const float inv = 1.0f / sum;
        int* ep = EIDX + (size_t)t * 128 + h * 16 + 8 * p; float* gp = GATE + (size_t)t * 128 + h * 16 + 8 * p;
#pragma unroll
        for (int k = 0; k < 8; ++k) { const int kk = k + 8; ep[k] = p ? te[kk] : te[k]; gp[k] = (p ? ex[kk] : ex[k]) * inv; }
    }
}

typedef __bf16 bf16x2_t __attribute__((ext_vector_type(2)));
typedef float f32x2_t __attribute__((ext_vector_type(2)));
__device__ __forceinline__ float dot2_fp8(unsigned w, bool hi, unsigned hpk, float acc) {
    const bf16x2_t c = hi ? __builtin_amdgcn_cvt_scalef32_pk_bf16_fp8((int)w, 1.0f, true) : __builtin_amdgcn_cvt_scalef32_pk_bf16_fp8((int)w, 1.0f, false);
    return __builtin_amdgcn_fdot2_f32_bf16(c, __builtin_bit_cast(bf16x2_t, hpk), acc, false);
}
__device__ __forceinline__ void phase_peer(const Args& A, LAS unsigned char* lds) {
    unsigned char* ws = A.ws;
    const bf16* H2 = (const bf16*)(ws + WS_H2); const unsigned char* U8 = ws + WS_U8; const unsigned char* V8 = ws + WS_V8;
    const float* SU = (const float*)(ws + WS_SU); const float* SV = (const float*)(ws + WS_SV);
    const int* EIDX = (const int*)(ws + WS_EIDX); const float* GATE = (const float*)(ws + WS_GATE);
    const float* ada = (const float*)(ws + WS_ADA);
    const int tid = threadIdx.x, lane = tid & 63, wave = tid >> 6, grp = lane >> 4, r = lane & 15;
    LAS float* sd = (LAS float*)lds + wave * 128;
    const int gw = blockIdx.x * NWAVES + wave, NGW = gridDim.x * NWAVES;
    for (int t = gw; t < T; t += NGW) {
        const int b = t / SEQ;
        const int e_lo = EIDX[(size_t)t * 128 + lane], e_hi = EIDX[(size_t)t * 128 + 64 + lane];
        const float g_lo = GATE[(size_t)t * 128 + lane], g_hi = GATE[(size_t)t * 128 + 64 + lane];
        const float su_lo = SU[e_lo], su_hi = SU[e_hi], sv_lo = SV[e_lo], sv_hi = SV[e_hi];
        unsigned hq[8][8];
        { const v4u* hp = (const v4u*)(H2 + (size_t)t * DM) + 2 * r;
#pragma unroll
          for (int it = 0; it < 8; ++it) { const v4u a = hp[32 * it], c = hp[32 * it + 1];
              hq[it][0] = a.x; hq[it][1] = a.y; hq[it][2] = a.z; hq[it][3] = a.w; hq[it][4] = c.x; hq[it][5] = c.y; hq[it][6] = c.z; hq[it][7] = c.w; } }
        v4u ub[2][8];
#define PEER_ULOAD(buf, qd) do { const int _ei = 4 * (qd) + grp; const int _e = __shfl((_ei < 64) ? e_lo : e_hi, _ei & 63); \
            const v4u* _up = (const v4u*)(U8 + (size_t)_e * DM) + r; _Pragma("unroll") for (int it = 0; it < 8; ++it) ub[buf][it] = _up[16 * it]; } while (0)
#define PEER_UCOMP(buf, qd) do { float s0 = 0.f, s1 = 0.f; _Pragma("unroll") for (int it = 0; it < 8; ++it) { const v4u u4 = ub[buf][it]; \
                s0 = dot2_fp8(u4.x, false, hq[it][0], s0); s1 = dot2_fp8(u4.x, true, hq[it][1], s1); s0 = dot2_fp8(u4.y, false, hq[it][2], s0); s1 = dot2_fp8(u4.y, true, hq[it][3], s1); \
                s0 = dot2_fp8(u4.z, false, hq[it][4], s0); s1 = dot2_fp8(u4.z, true, hq[it][5], s1); s0 = dot2_fp8(u4.w, false, hq[it][6], s0); s1 = dot2_fp8(u4.w, true, hq[it][7], s1); } \
            float s = s0 + s1; s += __shfl_xor(s, 1); s += __shfl_xor(s, 2); s += __shfl_xor(s, 4); s += __shfl_xor(s, 8); if (r == 0) sd[4 * (qd) + grp] = s; } while (0)
        PEER_ULOAD(0, 0);
        for (int qd = 0; qd < 32; qd += 2) {
            PEER_ULOAD(1, qd + 1);
            PEER_UCOMP(0, qd);
            if (qd + 2 < 32) PEER_ULOAD(0, qd + 2);
            PEER_UCOMP(1, qd + 1);
        }
#undef PEER_ULOAD
#undef PEER_UCOMP
        LDS_WAIT(); asm volatile("" ::: "memory");
        const float d_lo = sd[lane] * su_lo, d_hi = sd[64 + lane] * su_hi;
        LDS_WAIT(); asm volatile("" ::: "memory");
        const float w_lo = sv_lo * g_lo * 0.5f * d_lo * (1.0f + erff(d_lo * 0.70710678f)), w_hi = sv_hi * g_hi * 0.5f * d_hi * (1.0f + erff(d_hi * 0.70710678f));
        float y[32];
#pragma unroll
        for (int j = 0; j < 32; ++j) y[j] = 0.f;
        v4u vb[2][4][2];
#define PEER_VLOAD(buf, e0) do { _Pragma("unroll") for (int k = 0; k < 4; ++k) { const int _ei = (e0) + k; const int _e = __builtin_amdgcn_readlane((_ei < 64) ? e_lo : e_hi, _ei & 63); \
            const v4u* _vp = (const v4u*)(V8 + (size_t)_e * DM) + lane; vb[buf][k][0] = _vp[0]; vb[buf][k][1] = _vp[64]; } } while (0)
#define PEER_VCOMP(buf, e0) do { _Pragma("unroll") for (int k = 0; k < 4; ++k) { const int _ei = (e0) + k; \
            const float w = __builtin_bit_cast(float, __builtin_amdgcn_readlane(__builtin_bit_cast(int, (_ei < 64) ? w_lo : w_hi), _ei & 63)); \
            _Pragma("unroll") for (int it = 0; it < 2; ++it) { const v4u v4 = vb[buf][k][it]; const unsigned wd[4] = {v4.x, v4.y, v4.z, v4.w}; \
                _Pragma("unroll") for (int q = 0; q < 4; ++q) { const f32x2_t lo2 = __builtin_amdgcn_cvt_pk_f32_fp8((int)wd[q], false), hi2 = __builtin_amdgcn_cvt_pk_f32_fp8((int)wd[q], true); \
                    y[16 * it + 4 * q] += w * lo2.x; y[16 * it + 4 * q + 1] += w * lo2.y; y[16 * it + 4 * q + 2] += w * hi2.x; y[16 * it + 4 * q + 3] += w * hi2.y; } } } } while (0)
        PEER_VLOAD(0, 0);
        for (int e0 = 0; e0 < 128; e0 += 8) {
            PEER_VLOAD(1, e0 + 4);
            PEER_VCOMP(0, e0);
            if (e0 + 8 < 128) PEER_VLOAD(0, e0 + 8);
            PEER_VCOMP(1, e0 + 4);
        }
#undef PEER_VLOAD
#undef PEER_VCOMP
        float* xr = A.out + (size_t)t * DM; float ssq = 0.f;
#pragma unroll
        for (int it = 0; it < 2; ++it)
#pragma unroll
            for (int q = 0; q < 4; ++q) { const int d = 16 * lane + 1024 * it + 4 * q; const f32x4 xv = *(const f32x4*)(xr + d);
                const f32x4 g2 = *(const f32x4*)(ada + (size_t)b * NADA + 5 * DM + d) + 1.0f;
#pragma unroll
                for (int e = 0; e < 4; ++e) { const float x2 = xv[e] + g2[e] * y[16 * it + 4 * q + e]; y[16 * it + 4 * q + e] = x2; ssq += x2 * x2; } }
        const float rstd = 1.0f / sqrtf(wave_sum(ssq) * (1.0f / DM) + EPS);
#pragma unroll
        for (int it = 0; it < 2; ++it)
#pragma unroll
            for (int q = 0; q < 4; ++q) { const int d = 16 * lane + 1024 * it + 4 * q; const f32x4 fn = *(const f32x4*)(A.final_norm + d);
                f32x4 o; o[0] = y[16 * it + 4 * q] * rstd * fn[0]; o[1] = y[16 * it + 4 * q + 1] * rstd * fn[1]; o[2] = y[16 * it + 4 * q + 2] * rstd * fn[2]; o[3] = y[16 * it + 4 * q + 3] * rstd * fn[3];
                *(f32x4*)(xr + d) = o; }
    }
}

__global__ void __launch_bounds__(NTHR, 2) fwd_kernel(Args args) {
    extern __shared__ __attribute__((aligned(16))) unsigned char lds_raw[];
    LAS unsigned char* lds = (LAS unsigned char*)lds_raw;
    volatile LAS unsigned* MISC = (volatile LAS unsigned*)(lds + MISC_OFF);
    const int tid = threadIdx.x, G = gridDim.x;
    unsigned char* ws = args.ws;
    for (int u = tid; u < (LDS_BYTES - LDSCTL_OFF) / 4; u += NTHR) ((LAS unsigned*)(lds + LDSCTL_OFF))[u] = 0u;
    __syncthreads();
    XcdBarrier bar; bar.bar = (unsigned*)(ws + WS_CTL) + CW_BAR; bar.x = 0; bar.st = nullptr;
    if (N_LAUNCHES == 1) bar = xcd_barrier_post((unsigned*)(ws + WS_CTL) + CW_BAR, MISC + 8);
    const int lo = args.ph_lo, hi = args.ph_hi;
#define IN(k) (lo <= (k) && (k) < hi)
#define SEAM(k) do { if (IN(k) && IN((k) + 1)) xcd_barrier(bar); } while (0)
    const float* ada = (const float*)(ws + WS_ADA);

    if (IN(0)) { phase_prologue(args, lds); } SEAM(0);
    if (IN(1)) { phase_modnorm(args.x, args.norm1, ada, args.b_ada, 0, (bf16*)(ws + WS_H1)); } SEAM(1);
    if (IN(2)) {
        pg8::Gemm g{(const bf16*)(ws + WS_H1), (const bf16*)(ws + WS_WIN), T, NIN, DM, DM, DM, 30, 0}; pg8::StaticOrder S; S.init(T, NIN, G, (int)blockIdx.x);
        EpiProj E{(bf16*)(ws + WS_P), (bf16*)(ws + WS_I), (bf16*)(ws + WS_GA), (bf16*)(ws + WS_GG), (unsigned*)(ws + WS_Q), (const float*)(ws + WS_LB)};
        pg8::gemm_phase<EpiProj, true>(lds, g, S, E);
    } SEAM(2);
    if (IN(3)) { phase_pool((const bf16*)(ws + WS_P), (bf16*)(ws + WS_POOLED)); } SEAM(3);
    if (IN(4)) {
        pg8::Gemm g{(const bf16*)(ws + WS_POOLED), (const bf16*)(ws + WS_POOLW), T, DM, 256, 1024, 256, 1, 256}; pg8::StaticOrder S; S.init(T, DM, G, (int)blockIdx.x);
        EpiPool E{(bf16*)(ws + WS_YA), (const bf16*)(ws + WS_GA), args.pool_scale};
        pg8::gemm_phase<EpiPool, true>(lds, g, S, E);
    } SEAM(4);
    if (IN(5)) { phase_hgrn_fast(args, lds); } SEAM(5);
    if (IN(6)) {
        pg8::Gemm g{(const bf16*)(ws + WS_MERGED), (const bf16*)(ws + WS_WOUT), T, DM, DM, DM, DM, 30, 0}; pg8::StaticOrder S; S.init(T, DM, G, (int)blockIdx.x);
        EpiRes E{args.x, args.out, ada, args.b_ada};
        pg8::gemm_phase<EpiRes, true>(lds, g, S, E);
    } SEAM(6);
    if (IN(7)) { phase_modnorm(args.out, args.norm2, ada, args.b_ada, 3 * DM, (bf16*)(ws + WS_H2)); } SEAM(7);
    if (IN(8)) {
        pg8::Gemm g{(const bf16*)(ws + WS_H2), (const bf16*)(ws + WS_WQ), T, DM, DM, DM, DM, 30, 0}; pg8::StaticOrder S; S.init(T, DM, G, (int)blockIdx.x);
        EpiBf16 E{(bf16*)(ws + WS_QP), DM};
        pg8::gemm_phase<EpiBf16, true>(lds, g, S, E);
    } SEAM(8);
    if (IN(9)) { phase_route(args, lds); } SEAM(9);
    if (IN(10)) { phase_peer(args, lds); }
#undef IN
#undef SEAM
}

extern "C" void kernel_launch(void* const* d_in, const int* in_sizes, int n_in, void* d_out, int out_size, void* d_ws, size_t ws_size, hipStream_t stream) {
    static int grid = 0;
    if (grid == 0) {
        if (n_in != 17 || in_sizes[0] != T * DM || out_size != T * DM || ws_size < WS_END) {
            fprintf(stderr, "kernel_launch: unexpected shapes (n_in %d, in0 %d, out %d, ws %zu < %zu); nothing launched\n", n_in, n_in > 0 ? in_sizes[0] : -1, out_size, ws_size, (size_t)WS_END); grid = -1; return; }
        int dev = 0, cus = 0, per_cu = 0;
        if (hipGetDevice(&dev) != hipSuccess || hipDeviceGetAttribute(&cus, hipDeviceAttributeMultiprocessorCount, dev) != hipSuccess) { fprintf(stderr, "kernel_launch: device query failed\n"); grid = -1; return; }
        if (hipFuncSetAttribute((const void*)fwd_kernel, hipFuncAttributeMaxDynamicSharedMemorySize, LDS_BYTES) != hipSuccess) { fprintf(stderr, "kernel_launch: hipFuncSetAttribute failed\n"); grid = -1; return; }
        if (hipOccupancyMaxActiveBlocksPerMultiprocessor(&per_cu, (const void*)fwd_kernel, NTHR, LDS_BYTES) != hipSuccess || per_cu < 1) { fprintf(stderr, "kernel_launch: occupancy query reports %d blocks per CU\n", per_cu); }
        (void)hipGetLastError();
        grid = cus;
    }
    if (grid < 0) return;
    (void)hipMemsetAsync((char*)d_ws + WS_CTL, 0, CTL_ZERO_BYTES, stream);
    Args a{};
    a.x = (const float*)d_in[0]; a.c = (const float*)d_in[1]; a.w_ada = (const float*)d_in[2]; a.b_ada = (const float*)d_in[3]; a.norm1 = (const float*)d_in[4];
    a.w_in = (const float*)d_in[5]; a.pool_w = (const float*)d_in[6]; a.pool_scale = (const float*)d_in[7]; a.lb_logits = (const float*)d_in[8]; a.hg_norm = (const float*)d_in[9];
    a.w_out = (const float*)d_in[10]; a.norm2 = (const float*)d_in[11]; a.peer_wq = (const float*)d_in[12]; a.peer_keys = (const float*)d_in[13]; a.peer_u = (const float*)d_in[14];
    a.peer_v = (const float*)d_in[15]; a.final_norm = (const float*)d_in[16];
    a.out = (float*)d_out; a.ws = (unsigned char*)d_ws;
    if (N_LAUNCHES == 1) {
        a.ph_lo = 0; a.ph_hi = N_PHASES; a.li = 0;
        hipLaunchKernelGGL(fwd_kernel, dim3(grid), dim3(NTHR), LDS_BYTES, stream, a);
    } else {
        for (int li = 0; li < N_PHASES; ++li) { a.ph_lo = li; a.ph_hi = li + 1; a.li = li; hipLaunchKernelGGL(fwd_kernel, dim3(grid), dim3(NTHR), LDS_BYTES, stream, a); }
    }
    const hipError_t le = hipPeekAtLastError();
    if (le != hipSuccess) fprintf(stderr, "kernel_launch: launch failed: %s\n", hipGetErrorName(le));
}
```

```cpp
#include <hip/hip_runtime.h>
#include <cstdio>
#include <cstdint>

#ifndef MK_N_LAUNCHES
#define MK_N_LAUNCHES 1
#endif

__device__ __forceinline__ int tid_opaque() { int t = threadIdx.x; asm volatile("" : "+v"(t)); return t; }

namespace pg8 {
#define PG8_LAS __attribute__((address_space(3)))
typedef unsigned short bf16_t;
typedef short bf16x8 __attribute__((ext_vector_type(8)));
typedef float f32x4 __attribute__((ext_vector_type(4)));
typedef unsigned u32x4 __attribute__((ext_vector_type(4)));
constexpr int BM = 256, BK = 64, HALF = 128, HTB = HALF * BK * 2  , STAGE_BYTES = 8 * HTB, NXCD = 8, WGM = 8;

__host__ __device__ __forceinline__ int lds_byte(int r, int c) { const int st = (r >> 4) * 2 + (c >> 5), rr = r & 15, cc = c & 31, ob = rr * 64 + cc * 2; return st * 1024 + (ob ^ (((ob >> 9) & 1) << 5)); }
__host__ __device__ __forceinline__ void stage_rc(int b, int& R, int& C) { const int st = b / 1024, sb = b % 1024, swz = sb ^ (((sb >> 9) & 1) << 5); R = (st >> 1) * 16 + swz / 64; C = (st & 1) * 32 + (swz % 64) / 2; }
__host__ __device__ __forceinline__ int perm32(int rho) { const int n = rho >> 4, i = rho & 15; return 8 * (i >> 2) + 4 * n + (i & 3); }

struct Unit { int pm, pn; };
struct Gemm { const bf16_t* A; const bf16_t* Bt; int M, N, K, lda, ldb, a_gshift, a_gstride; };

struct StaticOrder {
    int nM, nN, nwg, G, c;
    __host__ __device__ void init(int M, int N, int G_, int c_) { nM = M / BM; nN = N / BM; nwg = nM * nN; G = G_; c = c_; }
    __host__ __device__ bool next(int i, Unit& u) const {
        const long L = (long)i * G + c; if (L >= nwg) return false;
        int wgid = (int)L; { const int q = nwg / NXCD, r = nwg % NXCD, xcd = wgid % NXCD, off = wgid / NXCD; wgid = (xcd < r ? xcd * (q + 1) : r * (q + 1) + (xcd - r) * q) + off; }
        const int nig = WGM * nN, gid = wgid / nig, fm = gid * WGM, gsz = (nM - fm) < WGM ? (nM - fm) : WGM;
        u.pm = fm + ((wgid % nig) % gsz); u.pn = (wgid % nig) / gsz; return true;
    }
};

__device__ __forceinline__ unsigned cvt_pk_bf16(float lo, float hi) { unsigned r; asm volatile("v_cvt_pk_bf16_f32 %0, %1, %2" : "=v"(r) : "v"(lo), "v"(hi)); return r; }

template <class Epi, bool ALIGN_EPI>
__device__ __forceinline__ void gemm_phase(PG8_LAS unsigned char* lds, const Gemm g, const StaticOrder& S, const Epi& E) {
    const int tid = tid_opaque(), wid = __builtin_amdgcn_readfirstlane(tid >> 6), lane = tid & 63, wr = wid >> 2, wc = wid & 3, fr = lane & 15, fq = lane >> 4;
    const int K = g.K, nt = K / BK;
    unsigned voffA[2], voffB[2];
#pragma unroll
    for (int i = 0; i < 2; ++i) { int R, C; stage_rc(tid * 16 + i * 8192, R, C); const int Rb = Epi::PERM ? ((R & ~31) + perm32(R & 31)) : R;
        voffA[i] = (unsigned)(R * g.lda + C) * 2u; voffB[i] = (unsigned)(Rb * g.ldb + C) * 2u; }
    const size_t kstep = (size_t)(BK * 2);
    const size_t hstepA = (size_t)HALF * g.lda * 2, hstepB = (size_t)HALF * g.ldb * 2;
    const size_t tstepA = 2 * hstepA, tstepB = 2 * hstepB;
    const unsigned ldsw = (unsigned)wid * 1024u;
    const int aoff = lds_byte(wr * 64 + fr, fq * 8), boff = lds_byte(wc * 32 + fr, fq * 8);
#define PG8_SA(b, h) (((b) * 2 + (h)) * HTB)
#define PG8_SB(b, h) ((4 + (b) * 2 + (h)) * HTB)
#define PG8_STAGE(bufoff, gbase, voff) do { _Pragma("unroll") for (int _i = 0; _i < 2; ++_i) \
        __builtin_amdgcn_global_load_lds((const unsigned*)((const char*)(gbase) + (voff)[_i]), (PG8_LAS unsigned*)(lds + (bufoff) + ldsw + _i * 8192), 16, 0, 0); } while (0)
#define PG8_LDA(dst, b, h) do { _Pragma("unroll") for (int m = 0; m < 4; ++m) _Pragma("unroll") for (int k = 0; k < 2; ++k) dst[m][k] = *(const PG8_LAS bf16x8*)(lds + PG8_SA(b, h) + aoff + m * 2048 + k * 1024); } while (0)
#define PG8_LDB(dst, b, h) do { _Pragma("unroll") for (int n = 0; n < 2; ++n) _Pragma("unroll") for (int k = 0; k < 2; ++k) dst[n][k] = *(const PG8_LAS bf16x8*)(lds + PG8_SB(b, h) + boff + n * 2048 + k * 1024); } while (0)
#define PG8_MMA(ai, bj, At, Bt) do { __builtin_amdgcn_s_setprio(1); _Pragma("unroll") for (int m = 0; m < 4; ++m) _Pragma("unroll") for (int n = 0; n < 2; ++n) _Pragma("unroll") for (int k = 0; k < 2; ++k) \
        acc[ai][bj][m][n] = __builtin_amdgcn_mfma_f32_16x16x32_bf16(Bt[n][k], At[m][k], acc[ai][bj][m][n], 0, 0, 0); __builtin_amdgcn_s_setprio(0); } while (0)
#define PG8_WAIT_V(n) asm volatile("s_waitcnt vmcnt(" #n ")" ::: "memory")
#define PG8_WAIT_L(n) asm volatile("s_waitcnt lgkmcnt(" #n ")" ::: "memory")
#define PG8_BAR __builtin_amdgcn_s_barrier()
#define PG8_SCHED __builtin_amdgcn_sched_barrier(0)
#define PG8_UA(u) ((const char*)g.A + (size_t)(u).pm * tstepA + (size_t)(((u).pn >> g.a_gshift) * g.a_gstride) * 2)
#define PG8_UB(u) ((const char*)g.Bt + (size_t)(u).pn * tstepB)
    Unit cur, nxt; int ui = 0;
    if (!S.next(0, cur)) return;
    f32x4 acc[2][2][4][2];
#pragma unroll
    for (int a = 0; a < 2; ++a)
#pragma unroll
        for (int b = 0; b < 2; ++b)
#pragma unroll
            for (int m = 0; m < 4; ++m)
#pragma unroll
                for (int n = 0; n < 2; ++n) acc[a][b][m][n] = (f32x4){0.f, 0.f, 0.f, 0.f};
    bf16x8 At[4][2], B0[2][2], B1[2][2];
    const char* cA = PG8_UA(cur); const char* cB = PG8_UB(cur);
    PG8_STAGE(PG8_SB(0, 0), cB, voffB); PG8_STAGE(PG8_SB(0, 1), cB + hstepB, voffB); PG8_STAGE(PG8_SA(0, 0), cA, voffA); PG8_STAGE(PG8_SA(0, 1), cA + hstepA, voffA);
    if (wr == 1) PG8_BAR;
    PG8_WAIT_V(2); PG8_BAR;
    PG8_STAGE(PG8_SB(1, 0), cB + kstep, voffB); PG8_STAGE(PG8_SA(1, 0), cA + kstep, voffA); PG8_STAGE(PG8_SB(1, 1), cB + hstepB + kstep, voffB);
    PG8_WAIT_V(6); PG8_BAR;
    for (;;) {
        const bool has_next = S.next(ui + 1, nxt);
        const char* nA = has_next ? PG8_UA(nxt) : cA; const char* nB = has_next ? PG8_UB(nxt) : cB;
#pragma nounroll
        for (int t = 0; t < nt; t += 2) {
            const bool last = (t == nt - 2);
            const char* a1 = cA + (size_t)(t + 1) * kstep;
            const char* a2 = last ? nA : cA + (size_t)(t + 2) * kstep; const char* b2 = last ? nB : cB + (size_t)(t + 2) * kstep;
            const char* a3 = a2 + kstep; const char* b3 = b2 + kstep;
            PG8_LDB(B0, 0, 0); PG8_LDB(B1, 0, 1); PG8_SCHED; PG8_LDA(At, 0, 0); PG8_STAGE(PG8_SA(1, 1), a1 + hstepA, voffA);
            PG8_WAIT_V(8); PG8_WAIT_L(0); PG8_BAR; PG8_MMA(0, 0, At, B0); PG8_MMA(0, 1, At, B1); PG8_BAR; PG8_SCHED;
            PG8_LDA(At, 0, 1); PG8_STAGE(PG8_SB(0, 0), b2, voffB); PG8_STAGE(PG8_SB(0, 1), b2 + hstepB, voffB); PG8_STAGE(PG8_SA(0, 0), a2, voffA);
            PG8_WAIT_V(8); PG8_WAIT_L(0); PG8_BAR; PG8_MMA(1, 0, At, B0); PG8_MMA(1, 1, At, B1); PG8_BAR; PG8_SCHED;
            PG8_LDB(B0, 1, 0); PG8_LDB(B1, 1, 1); PG8_SCHED; PG8_LDA(At, 1, 0); PG8_STAGE(PG8_SA(0, 1), a2 + hstepA, voffA);
            PG8_WAIT_V(8); PG8_WAIT_L(0); PG8_BAR; PG8_MMA(0, 0, At, B0); PG8_MMA(0, 1, At, B1); PG8_BAR; PG8_SCHED;
            PG8_LDA(At, 1, 1); PG8_STAGE(PG8_SB(1, 0), b3, voffB); PG8_STAGE(PG8_SB(1, 1), b3 + hstepB, voffB); PG8_STAGE(PG8_SA(1, 0), a3, voffA);
            PG8_WAIT_V(8); PG8_WAIT_L(0); PG8_BAR; PG8_MMA(1, 0, At, B0); PG8_MMA(1, 1, At, B1); PG8_BAR; PG8_SCHED;
        }
        if constexpr (ALIGN_EPI) { if (wr == 0) PG8_BAR; }
        { const int t2 = tid_opaque(), w2 = __builtin_amdgcn_readfirstlane(t2 >> 6), l2 = t2 & 63; E(acc, cur, w2 >> 2, w2 & 3, l2 & 15, l2 >> 4); }
        if (!has_next) break;
#pragma unroll
        for (int a = 0; a < 2; ++a)
#pragma unroll
            for (int b = 0; b < 2; ++b)
#pragma unroll
                for (int m = 0; m < 4; ++m)
#pragma unroll
                    for (int n = 0; n < 2; ++n) acc[a][b][m][n] = (f32x4){0.f, 0.f, 0.f, 0.f};
        cur = nxt; cA = nA; cB = nB; ++ui;
        if constexpr (ALIGN_EPI) { if (wr == 1) PG8_BAR; }
    }
    PG8_WAIT_V(0);
    if constexpr (!ALIGN_EPI) { if (wr == 0) PG8_BAR; }
    PG8_BAR;
#undef PG8_SA
#undef PG8_SB
#undef PG8_STAGE
#undef PG8_LDA
#undef PG8_LDB
#undef PG8_MMA
#undef PG8_WAIT_V
#undef PG8_WAIT_L
#undef PG8_BAR
#undef PG8_SCHED
#undef PG8_UA
#undef PG8_UB
}
}

constexpr int NWAVES = 8, NTHR = 512;
constexpr int T = 16384, DM = 2048, SEQ = 2048, NBATCH = 8, NIN = 13312, NADA = 12288;
constexpr int N_PHASES = 11;
constexpr int N_LAUNCHES = MK_N_LAUNCHES;
constexpr float EPS = 1e-6f;

constexpr size_t MiB = 1u << 20;
constexpr size_t WS_CTL = 0, CTL_ZERO_BYTES = 1 * MiB;
constexpr size_t WS_ADA = 512 * 1024;
constexpr size_t WS_WOUT = 1 * MiB, WS_WQ = 9 * MiB, WS_POOLW = 17 * MiB, WS_KEYS = 18 * MiB, WS_LB = 19 * MiB;
constexpr size_t WS_WIN = 20 * MiB, WS_H1 = 72 * MiB, WS_P = 136 * MiB, WS_GA = 168 * MiB, WS_Q = 232 * MiB, WS_LF = 296 * MiB, WS_I = 360 * MiB, WS_GG = 424 * MiB;
constexpr size_t WS_U = 488 * MiB, WS_V = 552 * MiB, WS_END = 616 * MiB;
constexpr size_t WS_POOLED = 20 * MiB, WS_YA = 72 * MiB, WS_MERGED = 552 * MiB, WS_H2 = 232 * MiB, WS_QP = 296 * MiB, WS_EIDX = 360 * MiB, WS_GATE = 368 * MiB;
constexpr size_t WS_SU = WS_LB + 64 * 1024, WS_SV = WS_LB + 128 * 1024;
constexpr size_t WS_U8 = WS_U, WS_V8 = WS_U + 32 * MiB;
constexpr int CW_BAR = 4096;

constexpr int RING_BYTES = 131072;
constexpr int LDSCTL_OFF = RING_BYTES, MISC_OFF = LDSCTL_OFF + 320;
constexpr int LDS_BYTES = 147456;

#define GAS __attribute__((address_space(1)))
#define LAS __attribute__((address_space(3)))
typedef unsigned short bf16;
typedef unsigned v4u __attribute__((ext_vector_type(4)));
typedef unsigned v2u __attribute__((ext_vector_type(2)));
typedef float f32x4 __attribute__((ext_vector_type(4)));
typedef GAS unsigned gu32;
#define RLX_AGENT __ATOMIC_RELAXED, __HIP_MEMORY_SCOPE_AGENT
#define LDS_WAIT() asm volatile("s_waitcnt lgkmcnt(0)" ::: "memory")
__device__ __forceinline__ unsigned f2bf(float f) { unsigned u = __builtin_bit_cast(unsigned, f); return (u + 0x7fffu + ((u >> 16) & 1u)) >> 16; }
__device__ __forceinline__ unsigned pk2(float lo, float hi) { return pg8::cvt_pk_bf16(lo, hi); }
__device__ __forceinline__ float bflo(unsigned w) { return __builtin_bit_cast(float, w << 16); }
__device__ __forceinline__ float bfhi(unsigned w) { return __builtin_bit_cast(float, w & 0xffff0000u); }
__device__ __forceinline__ float bf2f(bf16 b) { return __builtin_bit_cast(float, ((unsigned)b) << 16); }
__device__ __forceinline__ unsigned pkh2(float a, float b) { const _Float16 ha = (_Float16)a, hb = (_Float16)b; return (unsigned)__builtin_bit_cast(unsigned short, ha) | ((unsigned)__builtin_bit_cast(unsigned short, hb) << 16); }
__device__ __forceinline__ float h2f(unsigned short h) { return (float)__builtin_bit_cast(_Float16, h); }
__device__ __forceinline__ float sigmoidf_(float z) { return 1.0f / (1.0f + __expf(-z)); }
__device__ __forceinline__ float wave_sum(float v) {
#pragma unroll
    for (int o = 1; o < 64; o <<= 1) v += __shfl_xor(v, o);
    return v;
}

#define XB_TMO      128
#define XB_XCNT(j)  (256  + 64 * (j))
#define XB_XSUB(j)  (1280 + 64 * (j))
#define XB_XGEN(j)  (2304 + 64 * (j))
#define XB_TOP      3328
#define XB_TOPGEN   3392
#define XCD_BAR_WORDS 3456
#define XB_SPIN_CAP (1u << 18)
__device__ __forceinline__ unsigned xb_ld(unsigned* p)              { return __hip_atomic_load(p, __ATOMIC_RELAXED, __HIP_MEMORY_SCOPE_AGENT); }
__device__ __forceinline__ unsigned xb_add(unsigned* p, unsigned v) { return __hip_atomic_fetch_add(p, v, __ATOMIC_RELAXED, __HIP_MEMORY_SCOPE_AGENT); }
__device__ __forceinline__ unsigned xb_xcc_id() { return (unsigned)__builtin_amdgcn_s_getreg((3 << 11) | 20) & 0xFu; }
#define XB_SPIN(cond, bar) do { unsigned _sp = 0; while (cond) { __builtin_amdgcn_s_sleep(1); \
    if ((++_sp & 255u) == 0u) { if (xb_ld(&(bar)[XB_TMO])) break; if (_sp > XB_SPIN_CAP) { atomicAdd(&(bar)[XB_TMO], 1u); break; } } } } while (0)
struct XcdBarrier { unsigned* bar; unsigned x; volatile LAS unsigned* st; };
__device__ __forceinline__ XcdBarrier xcd_barrier_post(unsigned* bar, volatile LAS unsigned* st) {
    XcdBarrier b; b.bar = bar; b.x = xb_xcc_id(); b.st = st;
    if (threadIdx.x == 0) (void)xb_add(&bar[XB_XCNT(b.x)], 1u);
    return b;
}
__device__ __forceinline__ void xcd_barrier_complete(unsigned* bar, unsigned x, unsigned& nloc, unsigned& nx) {
    const unsigned G = gridDim.x * gridDim.y * gridDim.z;
    unsigned sum, cnt, mine, sp = 0u;
    for (;;) {
        sum = 0u; cnt = 0u; mine = 0u;
#pragma unroll
        for (unsigned j = 0; j < 16; ++j) { const unsigned c = xb_ld(&bar[XB_XCNT(j)]); sum += c; cnt += (c > 0u) ? 1u : 0u; mine = (j == x) ? c : mine; }
        if (sum == G) break;
        __builtin_amdgcn_s_sleep(1);
        if ((++sp & 255u) == 0u) { if (xb_ld(&bar[XB_TMO])) break; if (sp > XB_SPIN_CAP) { atomicAdd(&bar[XB_TMO], 1u); break; } }
    }
    nloc = mine > 0u ? mine : 1u; nx = cnt > 0u ? cnt : 1u;
}
__device__ __forceinline__ void xcd_barrier(const XcdBarrier& b) {
    asm volatile("s_waitcnt vmcnt(0)" ::: "memory");
    __syncthreads();
    if (threadIdx.x == 0) {
        unsigned* bar = b.bar;
        __builtin_amdgcn_s_waitcnt(0);
        unsigned nloc = b.st[0], nx = b.st[1];
        if (nloc == 0u) { xcd_barrier_complete(bar, b.x, nloc, nx); b.st[0] = nloc; b.st[1] = nx; }
        const unsigned old = xb_add(&bar[XB_XSUB(b.x)], 1u);
        const unsigned gen = old / nloc;
        if (old + 1u == (gen + 1u) * nloc) {
            __builtin_amdgcn_fence(__ATOMIC_RELEASE, "agent");
            asm volatile("s_waitcnt vmcnt(0)" ::: "memory");
            const unsigned og = xb_add(&bar[XB_TOP], 1u);
            const unsigned tg = og / nx;
            if (og + 1u == (tg + 1u) * nx) xb_add(&bar[XB_TOPGEN], 1u);
            else XB_SPIN(xb_ld(&bar[XB_TOPGEN]) == tg, bar);
            __builtin_amdgcn_fence(__ATOMIC_ACQUIRE, "agent");
            xb_add(&bar[XB_XGEN(b.x)], 1u);
            asm volatile("s_waitcnt vmcnt(0)" ::: "memory");
        } else {
            XB_SPIN(xb_ld(&bar[XB_XGEN(b.x)]) == gen, bar);
            __builtin_amdgcn_fence(__ATOMIC_ACQUIRE, "agent");
            asm volatile("s_waitcnt vmcnt(0)" ::: "memory");
        }
    }
    __syncthreads();
}

struct Args {
    const float *x, *c, *w_ada, *b_ada, *norm1, *w_in, *pool_w, *pool_scale, *lb_logits, *hg_norm, *w_out, *norm2, *peer_wq, *peer_keys, *peer_u, *peer_v, *final_norm;
    float* out; unsigned char* ws; int ph_lo, ph_hi, li, pad;
};

struct EpiProj {
    static constexpr bool PERM = true;
    bf16 *P, *I, *GA, *GG; unsigned* LQ; const float* lb;
    __device__ __forceinline__ void operator()(const f32x4 (&acc)[2][2][4][2], const pg8::Unit& u, int wr, int wc, int fr, int fq) const {
        const int pn = u.pn, row0 = u.pm * 256 + wr * 64 + fr, cw = wc * 32 + 8 * fq;
        if (pn >= 36) {
            bf16* base = GG + (size_t)row0 * DM + (pn - 36) * 128 + cw;
#pragma unroll
            for (int ai = 0; ai < 2; ++ai)
#pragma unroll
                for (int m = 0; m < 4; ++m) {
                    float o[8];
#pragma unroll
                    for (int n = 0; n < 2; ++n)
#pragma unroll
                        for (int e = 0; e < 4; ++e) { const float gv = acc[ai][0][m][n][e], bv = acc[ai][1][m][n][e]; o[n * 4 + e] = gv * sigmoidf_(gv) * sigmoidf_(bv); }
                    v4u w; w.x = pk2(o[0], o[1]); w.y = pk2(o[2], o[3]); w.z = pk2(o[4], o[5]); w.w = pk2(o[6], o[7]);
                    *(v4u*)(base + (size_t)(ai * 128 + m * 16) * DM) = w;
                }
            return;
        }
        if (pn >= 4 && pn < 20) {
            const int cb = (pn - 4) * 128 + cw;
            const f32x4 la = *(const f32x4*)(lb + cb), lc = *(const f32x4*)(lb + cb + 4);
            const float lbv[8] = {la[0], la[1], la[2], la[3], lc[0], lc[1], lc[2], lc[3]};
            unsigned* base = LQ + (size_t)row0 * DM + cb;
#pragma unroll
            for (int ai = 0; ai < 2; ++ai)
#pragma unroll
                for (int m = 0; m < 4; ++m) {
                    unsigned o[8];
#pragma unroll
                    for (int n = 0; n < 2; ++n)
#pragma unroll
                        for (int e = 0; e < 4; ++e) { const float l = lbv[n * 4 + e]; const float lf = __logf(l + (1.0f - l) * sigmoidf_(acc[ai][1][m][n][e]));
                            o[n * 4 + e] = (unsigned)__builtin_bit_cast(unsigned short, (_Float16)lf) | (f2bf(acc[ai][0][m][n][e]) << 16); }
                    unsigned* rp = base + (size_t)(ai * 128 + m * 16) * DM;
                    *(v4u*)rp = (v4u){o[0], o[1], o[2], o[3]}; *(v4u*)(rp + 4) = (v4u){o[4], o[5], o[6], o[7]};
                }
            return;
        }
        bf16* dst; int ldc, cb; bool sig = false;
        if (pn < 4) { dst = P; ldc = 1024; cb = pn * 256; }
        else if (pn < 28) { dst = I; ldc = DM; cb = (pn - 20) * 256; }
        else { dst = GA; ldc = DM; cb = (pn - 28) * 256; sig = true; }
        bf16* base = dst + (size_t)row0 * ldc + cb + cw;
#pragma unroll
        for (int ai = 0; ai < 2; ++ai)
#pragma unroll
            for (int m = 0; m < 4; ++m)
#pragma unroll
                for (int bj = 0; bj < 2; ++bj) {
                    f32x4 v0 = acc[ai][bj][m][0], v1 = acc[ai][bj][m][1];
                    if (sig) {
#pragma unroll
                        for (int e = 0; e < 4; ++e) { v0[e] = sigmoidf_(v0[e]); v1[e] = sigmoidf_(v1[e]); } }
                    v4u w; w.x = pk2(v0[0], v0[1]); w.y = pk2(v0[2], v0[3]); w.z = pk2(v1[0], v1[1]); w.w = pk2(v1[2], v1[3]);
                    *(v4u*)(base + (size_t)(ai * 128 + m * 16) * ldc + bj * 128) = w;
                }
    }
};
struct EpiPool {
    static constexpr bool PERM = true;
    bf16* YA; const float* pool_scale;
    __device__ __forceinline__ void operator()(const f32x4 (&acc)[2][2][4][2], const pg8::Unit& u, int wr, int wc, int fr, int fq) const {
        const int row0 = u.pm * 256 + wr * 64 + fr, col0 = u.pn * 256 + wc * 32 + 8 * fq;
#pragma unroll
        for (int bj = 0; bj < 2; ++bj) {
            const f32x4 ps0 = *(const f32x4*)(pool_scale + col0 + bj * 128), ps1 = *(const f32x4*)(pool_scale + col0 + bj * 128 + 4);
#pragma unroll
            for (int ai = 0; ai < 2; ++ai)
#pragma unroll
                for (int m = 0; m < 4; ++m) { const size_t off = (size_t)(row0 + ai * 128 + m * 16) * DM + col0 + bj * 128;
                    const f32x4 v0 = acc[ai][bj][m][0] * ps0, v1 = acc[ai][bj][m][1] * ps1;
                    v4u w; w.x = pk2(v0[0], v0[1]); w.y = pk2(v0[2], v0[3]); w.z = pk2(v1[0], v1[1]); w.w = pk2(v1[2], v1[3]);
                    *(v4u*)(YA + off) = w; }
        }
    }
};
struct EpiRes {
    static constexpr bool PERM = false;
    const float* x; float* x1; const float* ada; const float* b_ada;
    __device__ __forceinline__ void operator()(const f32x4 (&acc)[2][2][4][2], const pg8::Unit& u, int wr, int wc, int fr, int fq) const {
        const int row0 = u.pm * 256 + wr * 64 + fr, col0 = u.pn * 256 + wc * 32 + 4 * fq, b = u.pm >> 3;
        f32x4 gv[2][2];
#pragma unroll
        for (int bj = 0; bj < 2; ++bj)
#pragma unroll
            for (int n = 0; n < 2; ++n) { const int c = 2 * DM + col0 + bj * 128 + n * 16; gv[bj][n] = *(const f32x4*)(ada + (size_t)b * NADA + c) + 1.0f; }
#pragma unroll
        for (int ai = 0; ai < 2; ++ai)
#pragma unroll
            for (int m = 0; m < 4; ++m) { const size_t off = (size_t)(row0 + ai * 128 + m * 16) * DM + col0;
#pragma unroll
                for (int bj = 0; bj < 2; ++bj)
#pragma unroll
                    for (int n = 0; n < 2; ++n) { const f32x4 xv = *(const f32x4*)(x + off + bj * 128 + n * 16); *(f32x4*)(x1 + off + bj * 128 + n * 16) = xv + gv[bj][n] * acc[ai][bj][m][n]; }
                asm volatile("" ::: "memory"); }
    }
};
struct EpiBf16 {
    static constexpr bool PERM = true;
    bf16* O; int ldc;
    __device__ __forceinline__ void operator()(const f32x4 (&acc)[2][2][4][2], const pg8::Unit& u, int wr, int wc, int fr, int fq) const {
        const int row0 = u.pm * 256 + wr * 64 + fr, col0 = u.pn * 256 + wc * 32 + 8 * fq;
#pragma unroll
        for (int ai = 0; ai < 2; ++ai)
#pragma unroll
            for (int m = 0; m < 4; ++m) { bf16* rowp = O + (size_t)(row0 + ai * 128 + m * 16) * ldc + col0;
#pragma unroll
                for (int bj = 0; bj < 2; ++bj) { const f32x4 v0 = acc[ai][bj][m][0], v1 = acc[ai][bj][m][1];
                    v4u w; w.x = pk2(v0[0], v0[1]); w.y = pk2(v0[2], v0[3]); w.z = pk2(v1[0], v1[1]); w.w = pk2(v1[2], v1[3]);
                    *(v4u*)(rowp + bj * 128) = w; } }
    }
};

__device__ __forceinline__ void transpose_item(const float* W, int K, int N, bf16* WT, int ldt, int k0, int n0, int drow0, LAS float* scr, int lane) {
#pragma unroll 8
    for (int i = 0; i < 32; ++i) { const int kk = 2 * i + (lane >> 5); scr[kk * 33 + (lane & 31)] = W[(size_t)(k0 + kk) * N + n0 + (lane & 31)]; }
    LDS_WAIT(); asm volatile("" ::: "memory");
    const int c = lane & 7;
#pragma unroll
    for (int j = 0; j < 4; ++j) { const int n = (lane >> 3) + 8 * j; const LAS float* s = scr + (8 * c) * 33 + n;
        v4u o; o.x = pk2(s[0 * 33], s[1 * 33]); o.y = pk2(s[2 * 33], s[3 * 33]); o.z = pk2(s[4 * 33], s[5 * 33]); o.w = pk2(s[6 * 33], s[7 * 33]);
        *(GAS v4u*)(WT + (size_t)(drow0 + n) * ldt + k0 + 8 * c) = o; }
    LDS_WAIT(); asm volatile("" ::: "memory");
}
__device__ __forceinline__ int win_dst_row(int col) {
    if (col < 1024) return col;
    if (col < 3072) { const int r = col - 1024; return 1024 + (r >> 7) * 256 + (r & 127); }
    if (col < 5120) { const int r = col - 3072; return 1024 + (r >> 7) * 256 + 128 + (r & 127); }
    if (col < 7168) return col;
    if (col < 9216) { const int r = col - 7168; return 9216 + (r >> 7) * 256 + (r & 127); }
    if (col < 11264) return 7168 + (col - 9216);
    { const int r = col - 11264; return 9216 + (r >> 7) * 256 + 128 + (r & 127); }
}
__device__ __forceinline__ void cvt_bf16_stream(const float* src, bf16* dst, size_t n, size_t gid, size_t gstride) {
    for (size_t i = gid * 8; i < n; i += gstride * 8) { const f32x4 a = *(const f32x4*)(src + i), b = *(const f32x4*)(src + i + 4);
        v4u w; w.x = pk2(a[0], a[1]); w.y = pk2(a[2], a[3]); w.z = pk2(b[0], b[1]); w.w = pk2(b[2], b[3]); *(v4u*)(dst + i) = w; }
}
__device__ __forceinline__ void quantize_uv(const Args& A, int gw, int NGW) {
    unsigned char* ws = A.ws; const int lane = tid_opaque() & 63;
    for (int it = gw; it < 2 * T; it += NGW) {
        const int e = it & (T - 1); const bool isv = it >= T;
        const float* src = (isv ? A.peer_v : A.peer_u) + (size_t)e * DM;
        unsigned char* dst = ws + (isv ? WS_V8 : WS_U8) + (size_t)e * DM;
        f32x4 a[8]; float am = 0.f;
#pragma unroll
        for (int j = 0; j < 4; ++j) { a[2 * j] = *(const f32x4*)(src + 8 * lane + 512 * j); a[2 * j + 1] = *(const f32x4*)(src + 8 * lane + 512 * j + 4); }
#pragma unroll
        for (int j = 0; j < 8; ++j) am = fmaxf(am, fmaxf(fmaxf(fabsf(a[j][0]), fabsf(a[j][1])), fmaxf(fabsf(a[j][2]), fabsf(a[j][3]))));
#pragma unroll
        for (int o = 1; o < 64; o <<= 1) am = fmaxf(am, __shfl_xor(am, o));
        const float sc = am > 0.f ? 440.0f / am : 1.0f, inv = am > 0.f ? am * (1.0f / 440.0f) : 1.0f;
#pragma unroll
        for (int j = 0; j < 4; ++j) { v2u w;
            int w0 = __builtin_amdgcn_cvt_pk_fp8_f32(a[2 * j][0] * sc, a[2 * j][1] * sc, 0, false); w0 = __builtin_amdgcn_cvt_pk_fp8_f32(a[2 * j][2] * sc, a[2 * j][3] * sc, w0, true);
            int w1 = __builtin_amdgcn_cvt_pk_fp8_f32(a[2 * j + 1][0] * sc, a[2 * j + 1][1] * sc, 0, false); w1 = __builtin_amdgcn_cvt_pk_fp8_f32(a[2 * j + 1][2] * sc, a[2 * j + 1][3] * sc, w1, true);
            w.x = (unsigned)w0; w.y = (unsigned)w1; *(v2u*)(dst + 8 * lane + 512 * j) = w; }
        if (lane == 0) ((float*)(ws + (isv ? WS_SV : WS_SU)))[e] = inv;
    }
}
__device__ __forceinline__ void phase_prologue(const Args& A, LAS unsigned char* lds) {
    const int tid = tid_opaque(), lane = tid & 63, wave = __builtin_amdgcn_readfirstlane(tid >> 6), G = gridDim.x;
    unsigned char* ws = A.ws;
    {
        LAS float* sc = (LAS float*)lds;
        LAS float* red = sc + 8 * DM;
        float* ada = (float*)(ws + WS_ADA);
        if ((int)blockIdx.x < NADA / 64) {
            for (int e = tid; e < 8 * DM; e += NTHR) { const float cv = A.c[e]; sc[e] = cv * sigmoidf_(cv); }
            __syncthreads();
        }
        for (int it = blockIdx.x; it < NADA / 64; it += G) {
            const int n = it * 64 + lane, k0 = wave * 256;
            float acc[8];
#pragma unroll
            for (int b = 0; b < 8; ++b) acc[b] = 0.f;
            for (int kk = 0; kk < 256; kk += 4) {
                float w[4];
#pragma unroll
                for (int j = 0; j < 4; ++j) w[j] = A.w_ada[(size_t)(k0 + kk + j) * NADA + n];
#pragma unroll
                for (int b = 0; b < 8; ++b) { const f32x4 s = *(const LAS f32x4*)(sc + b * DM + k0 + kk); acc[b] += s[0] * w[0] + s[1] * w[1] + s[2] * w[2] + s[3] * w[3]; }
            }
#pragma unroll
            for (int b = 0; b < 8; ++b) red[(wave * 8 + b) * 64 + lane] = acc[b];
            __syncthreads();
            { const int b = tid >> 6; float s = A.b_ada[n];
#pragma unroll
              for (int w8 = 0; w8 < 8; ++w8) s += red[(w8 * 8 + b) * 64 + lane];
              ada[b * NADA + n] = s; }
            __syncthreads();
        }
        __syncthreads();
    }
    {
        LAS float* scr = (LAS float*)(lds + wave * 16384);
        const int gw = blockIdx.x * NWAVES + wave, NGW = G * NWAVES;
        constexpr int I_IN = (DM / 64) * (NIN / 32), I_SQ = (DM / 64) * (DM / 32), I_PW = 4 * (256 / 64) * (512 / 32);
        for (int it = gw; it < I_IN + 2 * I_SQ + I_PW; it += NGW) {
            int r = it;
            if (r < I_IN) { const int nb = r % (NIN / 32), kb = r / (NIN / 32); transpose_item(A.w_in, DM, NIN, (bf16*)(ws + WS_WIN), DM, kb * 64, nb * 32, win_dst_row(nb * 32), scr, lane); continue; } r -= I_IN;
            if (r < I_SQ) { const int nb = r % (DM / 32), kb = r / (DM / 32); transpose_item(A.w_out, DM, DM, (bf16*)(ws + WS_WOUT), DM, kb * 64, nb * 32, nb * 32, scr, lane); continue; } r -= I_SQ;
            if (r < I_SQ) { const int nb = r % (DM / 32), kb = r / (DM / 32); transpose_item(A.peer_wq, DM, DM, (bf16*)(ws + WS_WQ), DM, kb * 64, nb * 32, nb * 32, scr, lane); continue; } r -= I_SQ;
            { const int g = r / 64, rr = r % 64, nb = rr % 16, kb = rr / 16;
              transpose_item(A.pool_w + (size_t)g * 256 * 512, 256, 512, (bf16*)(ws + WS_POOLW), 256, kb * 64, nb * 32, g * 512 + nb * 32, scr, lane); }
        }
    }
    {
        const size_t gid = (size_t)blockIdx.x * NTHR + tid, gs = (size_t)G * NTHR;
        cvt_bf16_stream(A.peer_keys, (bf16*)(ws + WS_KEYS), (size_t)8 * 2 * 128 * 128, gid, gs);
    }
    if (blockIdx.x == 0) { float* lb = (float*)(ws + WS_LB); for (int k = tid; k < DM; k += NTHR) lb[k] = sigmoidf_(A.lb_logits[k] - A.lb_logits[DM + k]); }
}

__device__ __forceinline__ void phase_modnorm(const float* xin, const float* gain, const float* ada, const float* b_ada, int soff, bf16* outp) {
    const int tid = tid_opaque(), lane = tid & 63, wave = tid >> 6;
    const int gw = blockIdx.x * NWAVES + wave, NGW = gridDim.x * NWAVES;
    for (int m = gw; m < T; m += NGW) {
        const int b = m / SEQ;
        const float* xr = xin + (size_t)m * DM;
        f32x4 v[8]; float s = 0.f;
#pragma unroll
        for (int j = 0; j < 8; ++j) { v[j] = *(const f32x4*)(xr + 4 * lane + 256 * j); s += (v[j][0] * v[j][0] + v[j][1] * v[j][1]) + (v[j][2] * v[j][2] + v[j][3] * v[j][3]); }
        const float rstd = 1.0f / sqrtf(wave_sum(s) * (1.0f / DM) + EPS);
        bf16* orow = outp + (size_t)m * DM;
#pragma unroll
        for (int j = 0; j < 8; ++j) { const int d = 4 * lane + 256 * j;
            const f32x4 gn = *(const f32x4*)(gain + d);
            const f32x4 sh = *(const f32x4*)(ada + (size_t)b * NADA + soff + d);
            const f32x4 sc = *(const f32x4*)(ada + (size_t)b * NADA + soff + DM + d) + 1.0f;
            const f32x4 o = v[j] * rstd * gn * sc + sh;
            v2u w; w.x = pk2(o[0], o[1]); w.y = pk2(o[2], o[3]); *(v2u*)(orow + d) = w; }
    }
}

__device__ __forceinline__ void phase_pool(const bf16* P, bf16* POOLED) {
    const size_t gid = (size_t)blockIdx.x * NTHR + tid_opaque(), gs = (size_t)gridDim.x * NTHR;
    for (size_t it = gid; it < (size_t)T * 128; it += gs) {
        const int t = (int)(it >> 7), ch = (int)(it & 127), g = ch >> 5, w = 2 << g, tl = t & (SEQ - 1), cnt = (tl + 1 < w) ? tl + 1 : w;
        const bf16* p = P + (size_t)t * 1024 + ch * 8;
        float s[8];
#pragma unroll
        for (int e = 0; e < 8; ++e) s[e] = 0.f;
        for (int k = 0; k < cnt; ++k) { const v4u q = *(const v4u*)(p - (size_t)k * 1024);
            s[0] += bflo(q.x); s[1] += bfhi(q.x); s[2] += bflo(q.y); s[3] += bfhi(q.y); s[4] += bflo(q.z); s[5] += bfhi(q.z); s[6] += bflo(q.w); s[7] += bfhi(q.w); }
        const v4u q0 = *(const v4u*)p; const float inv = 1.0f / (float)cnt;
        v4u o; o.x = pk2(s[0] * inv - bflo(q0.x), s[1] * inv - bfhi(q0.x)); o.y = pk2(s[2] * inv - bflo(q0.y), s[3] * inv - bfhi(q0.y));
        o.z = pk2(s[4] * inv - bflo(q0.z), s[5] * inv - bfhi(q0.z)); o.w = pk2(s[6] * inv - bflo(q0.w), s[7] * inv - bfhi(q0.w));
        *(v4u*)(POOLED + (size_t)t * 1024 + ch * 8) = o;
    }
}

constexpr int HG_LD = 144, HG_TILE = 64 * HG_LD * 2;
constexpr int HG_QT = 0, HG_KT = HG_TILE, HG_IL = 2 * HG_TILE, HG_AM = 3 * HG_TILE, HG_AMLD = 72;
constexpr int HG_VEC = HG_AM + 64 * HG_AMLD * 2, HG_PART = HG_VEC + 3 * 128 * 4, HG_OT = HG_PART + 4 * 128 * 4, HG_OTLD = 132, HG_END = HG_OT + 64 * HG_OTLD * 4;
static_assert(HG_END <= RING_BYTES, "hgrn LDS map");
typedef short s16x4 __attribute__((ext_vector_type(4)));
#define HG_BAR() do { asm volatile("s_waitcnt lgkmcnt(0)" ::: "memory"); __builtin_amdgcn_s_barrier(); asm volatile("" ::: "memory"); } while (0)
__device__ __forceinline__ pg8::bf16x8 hg_tr8(const LAS unsigned char* p, int rowbytes4) {
    const s16x4 lo = __builtin_amdgcn_ds_read_tr16_b64_v4i16((s16x4 LAS*)p), hi = __builtin_amdgcn_ds_read_tr16_b64_v4i16((s16x4 LAS*)(p + rowbytes4));
    pg8::bf16x8 o; o[0] = lo[0]; o[1] = lo[1]; o[2] = lo[2]; o[3] = lo[3]; o[4] = hi[0]; o[5] = hi[1]; o[6] = hi[2]; o[7] = hi[3]; return o;
}
__device__ __forceinline__ void hgrn_item(const Args& A, LAS unsigned char* lds, int item) {
    unsigned char* ws = A.ws;
    const unsigned* LQ = (const unsigned*)(ws + WS_Q); const bf16* I = (const bf16*)(ws + WS_I);
    const bf16* GG = (const bf16*)(ws + WS_GG); const bf16* YA = (const bf16*)(ws + WS_YA); const bf16* GA = (const bf16*)(ws + WS_GA); bf16* MG = (bf16*)(ws + WS_MERGED);
    const int tid = tid_opaque(), lane = tid & 63, w = __builtin_amdgcn_readfirstlane(tid >> 6), r = lane & 15, g = lane >> 4, q4 = r >> 2, p4 = lane & 3;
    const int ek = tid & 127, etq = tid >> 7, is = tid >> 3, iseg = tid & 7;
    const int b = item >> 4, h = item & 15, colbase = h * 128;
    const size_t row0 = (size_t)b * SEQ;
    LAS bf16* QT = (LAS bf16*)(lds + HG_QT); LAS bf16* KT = (LAS bf16*)(lds + HG_KT); LAS bf16* IL = (LAS bf16*)(lds + HG_IL); LAS bf16* AM = (LAS bf16*)(lds + HG_AM);
    LAS float* VEC = (LAS float*)(lds + HG_VEC); LAS float* PART = (LAS float*)(lds + HG_PART); LAS float* OT = (LAS float*)(lds + HG_OT);
    f32x4 Sacc[8];
#pragma unroll
    for (int m = 0; m < 8; ++m) Sacc[m] = (f32x4){0.f, 0.f, 0.f, 0.f};
    const int orow = tid >> 3, oseg = tid & 7;
    unsigned raw[16]; v4u ir[2];
    const int evo_ = 16 * etq * DM + ek, ivo_ = is * DM + 16 * iseg;
#define HG_LOADRAW(c) do { const size_t _u0 = (row0 + 64 * (c)) * DM + colbase; int evo = evo_, ivo = ivo_; asm volatile("" : "+v"(evo), "+v"(ivo)); \
        _Pragma("unroll") for (int j = 0; j < 16; ++j) { const unsigned* _lp = LQ + _u0 + (size_t)j * DM; raw[j] = _lp[evo]; } \
        const bf16* _ib = I + _u0; const v4u* _ip = (const v4u*)(_ib + ivo); ir[0] = _ip[0]; ir[1] = _ip[1]; } while (0)
    HG_LOADRAW(0);
    for (int c = 0; c < SEQ / 64; ++c) {
        float run = 0.f;
#pragma unroll
        for (int j = 0; j < 16; ++j) run += h2f((unsigned short)(raw[j] & 0xffffu));
        PART[etq * 128 + ek] = run;
        HG_BAR();
        const float p0 = PART[ek], p1 = PART[128 + ek], p2 = PART[256 + ek], p3 = PART[384 + ek];
        const float pre = (etq > 0 ? p0 : 0.f) + (etq > 1 ? p1 : 0.f) + (etq > 2 ? p2 : 0.f), rr = p0 + p1, tot = rr + p2 + p3;
        float cj = pre - rr;
#pragma unroll
        for (int j = 0; j < 16; ++j) {
            const float lfj = h2f((unsigned short)(raw[j] & 0xffffu)); cj += lfj;
            const float x = fminf(fmaxf(cj, -80.f), 80.f), e1 = __expf(x), f = __expf(lfj);
            const float qt = __builtin_bit_cast(float, raw[j] & 0xffff0000u) * e1, kt = (1.0f - f) * __builtin_amdgcn_rcpf(e1);
            QT[(16 * etq + j) * HG_LD + ek] = (bf16)f2bf(qt); KT[(16 * etq + j) * HG_LD + ek] = (bf16)f2bf(kt);
        }
        if (etq == 0) { VEC[ek] = __expf(fmaxf(rr, -80.f)); VEC[128 + ek] = __expf(tot - rr); VEC[256 + ek] = __expf(tot); }
        *(LAS v4u*)(IL + is * HG_LD + 16 * iseg) = ir[0]; *(LAS v4u*)(IL + is * HG_LD + 16 * iseg + 8) = ir[1];
        HG_BAR();
        if (c + 1 < SEQ / 64) HG_LOADRAW(c + 1);
        {
            const int tt = w >> 1;
#pragma unroll
            for (int st2 = 0; st2 < 2; ++st2) {
                const int st = 2 * (w & 1) + st2;
                f32x4 acc = (f32x4){0.f, 0.f, 0.f, 0.f};
                if (st <= tt) {
#pragma unroll
                    for (int ks = 0; ks < 4; ++ks) {
                        const pg8::bf16x8 af = *(const LAS pg8::bf16x8*)(KT + (16 * st + r) * HG_LD + 32 * ks + 8 * g);
                        const pg8::bf16x8 bf = *(const LAS pg8::bf16x8*)(QT + (16 * tt + r) * HG_LD + 32 * ks + 8 * g);
                        acc = __builtin_amdgcn_mfma_f32_16x16x32_bf16(af, bf, acc, 0, 0, 0);
                    }
                    const int t = 16 * tt + r, s0 = 16 * st + 4 * g;
#pragma unroll
                    for (int j = 0; j < 4; ++j) acc[j] = (s0 + j <= t) ? acc[j] : 0.f;
                }
                v2u pk; pk.x = pk2(acc[0], acc[1]); pk.y = pk2(acc[2], acc[3]);
                *(LAS v2u*)(AM + (16 * tt + r) * HG_AMLD + 16 * st + 4 * g) = pk;
            }
        }
        v4u yav[2], ggv[2], gav[2];
        { int ovo = orow * DM + 16 * oseg; asm volatile("" : "+v"(ovo));
          const size_t gu = (row0 + 64 * c) * DM + colbase; const bf16* _yp = YA + gu; const bf16* _gp = GG + gu; const bf16* _ap = GA + gu;
          yav[0] = *(const v4u*)(_yp + ovo); yav[1] = *(const v4u*)(_yp + ovo + 8); ggv[0] = *(const v4u*)(_gp + ovo); ggv[1] = *(const v4u*)(_gp + ovo + 8);
          gav[0] = *(const v4u*)(_ap + ovo); gav[1] = *(const v4u*)(_ap + ovo + 8); }
        HG_BAR();
        pg8::bf16x8 ifr[2];
#pragma unroll
        for (int ks = 0; ks < 2; ++ks) ifr[ks] = hg_tr8((const LAS unsigned char*)(IL + (32 * ks + 8 * g + q4) * HG_LD + 16 * w + 4 * p4), 4 * HG_LD * 2);
        f32x4 oacc[4];
#pragma unroll
        for (int tt = 0; tt < 4; ++tt) oacc[tt] = (f32x4){0.f, 0.f, 0.f, 0.f};
#pragma unroll
        for (int tt = 0; tt < 4; ++tt)
#pragma unroll
            for (int ks = 0; ks < 2; ++ks) { const pg8::bf16x8 af = *(const LAS pg8::bf16x8*)(AM + (16 * tt + r) * HG_AMLD + 32 * ks + 8 * g);
                oacc[tt] = __builtin_amdgcn_mfma_f32_16x16x32_bf16(af, ifr[ks], oacc[tt], 0, 0, 0); }
        __builtin_amdgcn_sched_barrier(0);
#pragma unroll
        for (int ks = 0; ks < 4; ++ks) {
            const f32x4 e0 = *(const LAS f32x4*)(VEC + 32 * ks + 4 * g), e1 = *(const LAS f32x4*)(VEC + 32 * ks + 16 + 4 * g);
            const f32x4 s0 = Sacc[2 * ks] * e0, s1 = Sacc[2 * ks + 1] * e1;
            v4u sb; sb.x = pk2(s0[0], s0[1]); sb.y = pk2(s0[2], s0[3]); sb.z = pk2(s1[0], s1[1]); sb.w = pk2(s1[2], s1[3]);
            const pg8::bf16x8 sfr = __builtin_bit_cast(pg8::bf16x8, sb);
#pragma unroll
            for (int tt = 0; tt < 4; ++tt) {
                const v2u a0 = *(const LAS v2u*)(QT + (16 * tt + r) * HG_LD + 32 * ks + 4 * g), a1 = *(const LAS v2u*)(QT + (16 * tt + r) * HG_LD + 32 * ks + 16 + 4 * g);
                v4u ab; ab.x = a0.x; ab.y = a0.y; ab.z = a1.x; ab.w = a1.y;
                oacc[tt] = __builtin_amdgcn_mfma_f32_16x16x32_bf16(__builtin_bit_cast(pg8::bf16x8, ab), sfr, oacc[tt], 0, 0, 0);
            }
            __builtin_amdgcn_sched_barrier(0);
        }
#pragma unroll
        for (int mt = 0; mt < 8; ++mt) {
            f32x4 P = (f32x4){0.f, 0.f, 0.f, 0.f};
#pragma unroll
            for (int ks = 0; ks < 2; ++ks) { const pg8::bf16x8 af = hg_tr8((const LAS unsigned char*)(KT + (32 * ks + 8 * g + q4) * HG_LD + 16 * mt + 4 * p4), 4 * HG_LD * 2);
                P = __builtin_amdgcn_mfma_f32_16x16x32_bf16(af, ifr[ks], P, 0, 0, 0); }
            const f32x4 el4 = *(const LAS f32x4*)(VEC + 128 + 16 * mt + 4 * g), d4 = *(const LAS f32x4*)(VEC + 256 + 16 * mt + 4 * g);
            Sacc[mt] = d4 * Sacc[mt] + el4 * P;
            if (mt & 1) __builtin_amdgcn_sched_barrier(0);
        }
#pragma unroll
        for (int tt = 0; tt < 4; ++tt)
#pragma unroll
            for (int j = 0; j < 4; ++j) OT[(16 * tt + 4 * g + j) * HG_OTLD + 16 * w + r] = oacc[tt][j];
        HG_BAR();
        {
            float o[16]; float ssq = 0.f;
#pragma unroll
            for (int q = 0; q < 4; ++q) { const f32x4 t4 = *(const LAS f32x4*)(OT + orow * HG_OTLD + 16 * oseg + 4 * q); o[4 * q] = t4[0]; o[4 * q + 1] = t4[1]; o[4 * q + 2] = t4[2]; o[4 * q + 3] = t4[3]; }
#pragma unroll
            for (int e = 0; e < 16; ++e) ssq += o[e] * o[e];
            ssq += __shfl_xor(ssq, 1); ssq += __shfl_xor(ssq, 2); ssq += __shfl_xor(ssq, 4);
            const float rstd = 1.0f / sqrtf(ssq * (1.0f / 128.0f) + EPS);
            const float* hn = A.hg_norm + colbase + 16 * oseg;
            bf16* mp = MG + (row0 + 64 * c) * DM + colbase;
            int ovo = orow * DM + 16 * oseg; asm volatile("" : "+v"(ovo));
#pragma unroll
            for (int hh = 0; hh < 2; ++hh) {
                const f32x4 n0 = *(const f32x4*)(hn + 8 * hh), n1 = *(const f32x4*)(hn + 8 * hh + 4);
                const v4u ya = yav[hh], gg = ggv[hh], ga = gav[hh]; v4u wv;
                wv.x = pk2(bflo(ya.x) * bflo(ga.x) + bflo(gg.x) * (o[8 * hh + 0] * rstd * n0[0]), bfhi(ya.x) * bfhi(ga.x) + bfhi(gg.x) * (o[8 * hh + 1] * rstd * n0[1]));
                wv.y = pk2(bflo(ya.y) * bflo(ga.y) + bflo(gg.y) * (o[8 * hh + 2] * rstd * n0[2]), bfhi(ya.y) * bfhi(ga.y) + bfhi(gg.y) * (o[8 * hh + 3] * rstd * n0[3]));
                wv.z = pk2(bflo(ya.z) * bflo(ga.z) + bflo(gg.z) * (o[8 * hh + 4] * rstd * n1[0]), bfhi(ya.z) * bfhi(ga.z) + bfhi(gg.z) * (o[8 * hh + 5] * rstd * n1[1]));
                wv.w = pk2(bflo(ya.w) * bflo(ga.w) + bflo(gg.w) * (o[8 * hh + 6] * rstd * n1[2]), bfhi(ya.w) * bfhi(ga.w) + bfhi(gg.w) * (o[8 * hh + 7] * rstd * n1[3]));
                *(v4u*)(mp + ovo + 8 * hh) = wv;
            }
        }
    }
#undef HG_LOADRAW
    HG_BAR();
}
__device__ __forceinline__ void phase_hgrn_fast(const Args& A, LAS unsigned char* lds) {
    const int G = gridDim.x, wave = tid_opaque() >> 6;
    const bool split = G >= 256;
    if (!split || (int)blockIdx.x < 128) for (int item = blockIdx.x; item < NBATCH * 16; item += (split ? 128 : G)) hgrn_item(A, lds, item);
    if (!split) quantize_uv(A, blockIdx.x * NWAVES + wave, G * NWAVES);
    else if ((int)blockIdx.x >= 128) quantize_uv(A, ((int)blockIdx.x - 128) * NWAVES + wave, (G - 128) * NWAVES);
}

__device__ __forceinline__ unsigned f2ord(float f) { const unsigned u = __builtin_bit_cast(unsigned, f); return u ^ ((u >> 31) ? 0xffffffffu : 0x80000000u); }
__device__ __forceinline__ float ord2f(unsigned o) { const unsigned u = o ^ ((o >> 31) ? 0x80000000u : 0xffffffffu); return __builtin_bit_cast(float, u); }
__device__ __forceinline__ float dot2bf(unsigned a, unsigned b, float c) { return c + bflo(a) * bflo(b) + bfhi(a) * bfhi(b); }
__device__ __forceinline__ void ce_desc(unsigned& a, unsigned& b) { const unsigned hi = a > b ? a : b, lo = a > b ? b : a; a = hi; b = lo; }
__device__ __forceinline__ void sort16_desc(unsigned (&x)[16]) {
#pragma unroll
    for (int k = 2; k <= 16; k <<= 1)
#pragma unroll
        for (int j = k >> 1; j > 0; j >>= 1)
#pragma unroll
            for (int i = 0; i < 16; ++i) { const int l = i ^ j; if (l > i) { if ((i & k) == 0) ce_desc(x[i], x[l]); else ce_desc(x[l], x[i]); } }
}
__device__ __forceinline__ void merge16_desc(unsigned (&x)[16]) {
#pragma unroll
    for (int j = 8; j > 0; j >>= 1)
#pragma unroll
        for (int i = 0; i < 16; ++i) { const int l = i ^ j; if (l > i) ce_desc(x[i], x[l]); }
}
constexpr int RT_KLD = 136;
__device__ __forceinline__ void phase_route(const Args& A, LAS unsigned char* lds) {
    unsigned char* ws = A.ws;
    const bf16* QP = (const bf16*)(ws + WS_QP); const bf16* KB = (const bf16*)(ws + WS_KEYS);
    int* EIDX = (int*)(ws + WS_EIDX); float* GATE = (float*)(ws + WS_GATE);
    const int tid = tid_opaque(), lane = tid & 63, w = __builtin_amdgcn_readfirstlane(tid >> 6), r = lane & 15, g = lane >> 4;
    LAS bf16* KL = (LAS bf16*)lds;
    int hl = -1;
    for (int item = blockIdx.x; item < 8 * (T / 128); item += gridDim.x) {
        const int h = item & 7, tile = item >> 3;
        if (h != hl) {
            __syncthreads();
            for (int e = tid; e < 4096; e += NTHR) { const int row = e >> 4, ch = e & 15;
                *(LAS v4u*)(KL + row * RT_KLD + ch * 8) = *(const v4u*)(KB + (size_t)(h * 256 + row) * 128 + ch * 8); }
            __syncthreads(); hl = h;
        }
        const int t = tile * 128 + 16 * w + r;
        unsigned lst[2][16];
#pragma unroll
        for (int p = 0; p < 2; ++p) {
            pg8::bf16x8 qf[4];
            { const bf16* qp = QP + (size_t)t * DM + h * 256 + p * 128 + 8 * g;
#pragma unroll
              for (int ks = 0; ks < 4; ++ks) qf[ks] = *(const pg8::bf16x8*)(qp + 32 * ks); }
            f32x4 acc[8];
#pragma unroll
            for (int mt = 0; mt < 8; ++mt) { acc[mt] = (f32x4){0.f, 0.f, 0.f, 0.f};
#pragma unroll
                for (int ks = 0; ks < 4; ++ks) { const pg8::bf16x8 af = *(const LAS pg8::bf16x8*)(KL + (p * 128 + 16 * mt + r) * RT_KLD + 32 * ks + 8 * g);
                    acc[mt] = __builtin_amdgcn_mfma_f32_16x16x32_bf16(af, qf[ks], acc[mt], 0, 0, 0); } }
            unsigned x0[16], x1[16];
#pragma unroll
            for (int mt = 0; mt < 4; ++mt)
#pragma unroll
                for (int j = 0; j < 4; ++j) { x0[4 * mt + j] = (f2ord(acc[mt][j]) & ~127u) | (unsigned)(16 * mt + 4 * g + j); x1[4 * mt + j] = (f2ord(acc[mt + 4][j]) & ~127u) | (unsigned)(16 * (mt + 4) + 4 * g + j); }
            sort16_desc(x0); sort16_desc(x1);
#pragma unroll
            for (int i = 0; i < 16; ++i) x0[i] = x0[i] > x1[15 - i] ? x0[i] : x1[15 - i];
            merge16_desc(x0);
#pragma unroll
            for (int off = 16; off <= 32; off <<= 1) {
#pragma unroll
                for (int i = 0; i < 16; ++i) x1[i] = (unsigned)__shfl_xor((int)x0[i], off);
#pragma unroll
                for (int i = 0; i < 16; ++i) x0[i] = x0[i] > x1[15 - i] ? x0[i] : x1[15 - i];
                merge16_desc(x0);
            }
#pragma unroll
            for (int i = 0; i < 16; ++i) lst[p][i] = x0[i];
        }
        float v0[16], v1[16]; int n0[16], n1[16];
#pragma unroll
        for (int j = 0; j < 16; ++j) { v0[j] = ord2f(lst[0][j] & ~127u); n0[j] = (int)(lst[0][j] & 127u) * 128; v1[j] = ord2f(lst[1][j] & ~127u); n1[j] = (int)(lst[1][j] & 127u); }
        float ts[16]; int te[16];
#pragma unroll
        for (int k = 0; k < 16; ++k) { ts[k] = v0[0] + v1[k]; te[k] = n0[0] + n1[k]; }
#pragma unroll
        for (int i = 1; i < 16; ++i)
#pragma unroll
            for (int j = 0; j < 16; ++j) if ((i + 1) * (j + 1) <= 16) {
                float sv = v0[i] + v1[j]; int ev = n0[i] + n1[j];
#pragma unroll
                for (int k = (i + 1) * (j + 1) - 1; k < 16; ++k) { const bool gt = sv > ts[k]; const float fs = gt ? ts[k] : sv; const int fe = gt ? te[k] : ev; ts[k] = gt ? sv : ts[k]; te[k] = gt ? ev : te[k]; sv = fs; ev = fe; }
            }
        float ex[16], sum = 0.f;
#pragma unroll
        for (int k = 0; k < 16; ++k) { ex[k] = __expf(ts[k] - ts[0]); sum += ex[k]; }
        const float inv = 1.0f / sum;
        v4u eo; f32x4 go;
#pragma unroll
        for (int q = 0; q < 4; ++q) { const int e = g == 0 ? te[q] : g == 1 ? te[4 + q] : g == 2 ? te[8 + q] : te[12 + q]; const float x = g == 0 ? ex[q] : g == 1 ? ex[4 + q] : g == 2 ? ex[8 + q] : ex[12 + q];
            eo[q] = (unsigned)e; go[q] = x * inv; }
        *(v4u*)(EIDX + (size_t)t * 128 + h * 16 + 4 * g) = eo; *(f32x4*)(GATE + (size_t)t * 128 + h * 16 + 4 * g) = go;
    }
    __syncthreads();
}

typedef __bf16 bf16x2_t __attribute__((ext_vector_type(2)));
typedef float f32x2_t __attribute__((ext_vector_type(2)));
__device__ __forceinline__ float dot2_fp8(unsigned w, bool hi, unsigned hpk, float acc) {
    const bf16x2_t c = hi ? __builtin_amdgcn_cvt_scalef32_pk_bf16_fp8((int)w, 1.0f, true) : __builtin_amdgcn_cvt_scalef32_pk_bf16_fp8((int)w, 1.0f, false);
    return __builtin_amdgcn_fdot2_f32_bf16(c, __builtin_bit_cast(bf16x2_t, hpk), acc, false);
}
__device__ __forceinline__ void phase_peer(const Args& A, LAS unsigned char* lds) {
    unsigned char* ws = A.ws;
    const bf16* H2 = (const bf16*)(ws + WS_H2); const unsigned char* U8 = ws + WS_U8; const unsigned char* V8 = ws + WS_V8;
    const float* SU = (const float*)(ws + WS_SU); const float* SV = (const float*)(ws + WS_SV);
    const int* EIDX = (const int*)(ws + WS_EIDX); const float* GATE = (const float*)(ws + WS_GATE);
    const float* ada = (const float*)(ws + WS_ADA);
    const int tid = tid_opaque(), lane = tid & 63, wave = tid >> 6, grp = lane >> 4, r = lane & 15;
    LAS float* sd = (LAS float*)lds + wave * 128;
    const int gw = blockIdx.x * NWAVES + wave, NGW = gridDim.x * NWAVES;
    for (int t = gw; t < T; t += NGW) {
        const int b = t / SEQ;
        const int e_lo = EIDX[(size_t)t * 128 + lane], e_hi = EIDX[(size_t)t * 128 + 64 + lane];
        const float g_lo = GATE[(size_t)t * 128 + lane], g_hi = GATE[(size_t)t * 128 + 64 + lane];
        const float su_lo = SU[e_lo], su_hi = SU[e_hi], sv_lo = SV[e_lo], sv_hi = SV[e_hi];
        unsigned hq[8][8];
        { const v4u* hp = (const v4u*)(H2 + (size_t)t * DM) + 2 * r;
#pragma unroll
          for (int it = 0; it < 8; ++it) { const v4u a = hp[32 * it], c = hp[32 * it + 1];
              hq[it][0] = a.x; hq[it][1] = a.y; hq[it][2] = a.z; hq[it][3] = a.w; hq[it][4] = c.x; hq[it][5] = c.y; hq[it][6] = c.z; hq[it][7] = c.w; } }
        v4u ub[2][8];
#define PEER_ULOAD(buf, qd) do { const int _ei = 4 * (qd) + grp; const int _e = __shfl((_ei < 64) ? e_lo : e_hi, _ei & 63); \
            const v4u* _up = (const v4u*)(U8 + (size_t)_e * DM) + r; _Pragma("unroll") for (int it = 0; it < 8; ++it) ub[buf][it] = _up[16 * it]; } while (0)
#define PEER_UCOMP(buf, qd) do { float s0 = 0.f, s1 = 0.f; _Pragma("unroll") for (int it = 0; it < 8; ++it) { const v4u u4 = ub[buf][it]; \
                s0 = dot2_fp8(u4.x, false, hq[it][0], s0); s1 = dot2_fp8(u4.x, true, hq[it][1], s1); s0 = dot2_fp8(u4.y, false, hq[it][2], s0); s1 = dot2_fp8(u4.y, true, hq[it][3], s1); \
                s0 = dot2_fp8(u4.z, false, hq[it][4], s0); s1 = dot2_fp8(u4.z, true, hq[it][5], s1); s0 = dot2_fp8(u4.w, false, hq[it][6], s0); s1 = dot2_fp8(u4.w, true, hq[it][7], s1); } \
            float s = s0 + s1; s += __shfl_xor(s, 1); s += __shfl_xor(s, 2); s += __shfl_xor(s, 4); s += __shfl_xor(s, 8); if (r == 0) sd[4 * (qd) + grp] = s; } while (0)
        PEER_ULOAD(0, 0);
        for (int qd = 0; qd < 32; qd += 2) {
            PEER_ULOAD(1, qd + 1);
            PEER_UCOMP(0, qd);
            if (qd + 2 < 32) PEER_ULOAD(0, qd + 2);
            PEER_UCOMP(1, qd + 1);
        }
#undef PEER_ULOAD
#undef PEER_UCOMP
        LDS_WAIT(); asm volatile("" ::: "memory");
        const float d_lo = sd[lane] * su_lo, d_hi = sd[64 + lane] * su_hi;
        LDS_WAIT(); asm volatile("" ::: "memory");
        const float w_lo = sv_lo * g_lo * 0.5f * d_lo * (1.0f + erff(d_lo * 0.70710678f)), w_hi = sv_hi * g_hi * 0.5f * d_hi * (1.0f + erff(d_hi * 0.70710678f));
        float y[32];
#pragma unroll
        for (int j = 0; j < 32; ++j) y[j] = 0.f;
        v4u vb[2][4][2];
#define PEER_VLOAD(buf, e0) do { _Pragma("unroll") for (int k = 0; k < 4; ++k) { const int _ei = (e0) + k; const int _e = __builtin_amdgcn_readlane((_ei < 64) ? e_lo : e_hi, _ei & 63); \
            const v4u* _vp = (const v4u*)(V8 + (size_t)_e * DM) + lane; vb[buf][k][0] = _vp[0]; vb[buf][k][1] = _vp[64]; } } while (0)
#define PEER_VCOMP(buf, e0) do { _Pragma("unroll") for (int k = 0; k < 4; ++k) { const int _ei = (e0) + k; \
            const float w = __builtin_bit_cast(float, __builtin_amdgcn_readlane(__builtin_bit_cast(int, (_ei < 64) ? w_lo : w_hi), _ei & 63)); \
            _Pragma("unroll") for (int it = 0; it < 2; ++it) { const v4u v4 = vb[buf][k][it]; const unsigned wd[4] = {v4.x, v4.y, v4.z, v4.w}; \
                _Pragma("unroll") for (int q = 0; q < 4; ++q) { const f32x2_t lo2 = __builtin_amdgcn_cvt_pk_f32_fp8((int)wd[q], false), hi2 = __builtin_amdgcn_cvt_pk_f32_fp8((int)wd[q], true); \
                    y[16 * it + 4 * q] += w * lo2.x; y[16 * it + 4 * q + 1] += w * lo2.y; y[16 * it + 4 * q + 2] += w * hi2.x; y[16 * it + 4 * q + 3] += w * hi2.y; } } } } while (0)
        PEER_VLOAD(0, 0);
        for (int e0 = 0; e0 < 128; e0 += 8) {
            PEER_VLOAD(1, e0 + 4);
            PEER_VCOMP(0, e0);
            if (e0 + 8 < 128) PEER_VLOAD(0, e0 + 8);
            PEER_VCOMP(1, e0 + 4);
        }
#undef PEER_VLOAD
#undef PEER_VCOMP
        float* xr = A.out + (size_t)t * DM; float ssq = 0.f;
#pragma unroll
        for (int it = 0; it < 2; ++it)
#pragma unroll
            for (int q = 0; q < 4; ++q) { const int d = 16 * lane + 1024 * it + 4 * q; const f32x4 xv = *(const f32x4*)(xr + d);
                const f32x4 g2 = *(const f32x4*)(ada + (size_t)b * NADA + 5 * DM + d) + 1.0f;
#pragma unroll
                for (int e = 0; e < 4; ++e) { const float x2 = xv[e] + g2[e] * y[16 * it + 4 * q + e]; y[16 * it + 4 * q + e] = x2; ssq += x2 * x2; } }
        const float rstd = 1.0f / sqrtf(wave_sum(ssq) * (1.0f / DM) + EPS);
#pragma unroll
        for (int it = 0; it < 2; ++it)
#pragma unroll
            for (int q = 0; q < 4; ++q) { const int d = 16 * lane + 1024 * it + 4 * q; const f32x4 fn = *(const f32x4*)(A.final_norm + d);
                f32x4 o; o[0] = y[16 * it + 4 * q] * rstd * fn[0]; o[1] = y[16 * it + 4 * q + 1] * rstd * fn[1]; o[2] = y[16 * it + 4 * q + 2] * rstd * fn[2]; o[3] = y[16 * it + 4 * q + 3] * rstd * fn[3];
                *(f32x4*)(xr + d) = o; }
    }
}

__global__ void __launch_bounds__(NTHR, 2) fwd_kernel(Args args) {
    extern __shared__ __attribute__((aligned(16))) unsigned char lds_raw[];
    LAS unsigned char* lds = (LAS unsigned char*)lds_raw;
    volatile LAS unsigned* MISC = (volatile LAS unsigned*)(lds + MISC_OFF);
    const int tid = tid_opaque(), G = gridDim.x;
    unsigned char* ws = args.ws;
    for (int u = tid; u < (LDS_BYTES - LDSCTL_OFF) / 4; u += NTHR) ((LAS unsigned*)(lds + LDSCTL_OFF))[u] = 0u;
    __syncthreads();
    XcdBarrier bar; bar.bar = (unsigned*)(ws + WS_CTL) + CW_BAR; bar.x = 0; bar.st = nullptr;
    if (N_LAUNCHES == 1) bar = xcd_barrier_post((unsigned*)(ws + WS_CTL) + CW_BAR, MISC + 8);
    const int lo = args.ph_lo, hi = args.ph_hi;
#define IN(k) (lo <= (k) && (k) < hi)
#define SEAM(k) do { if (IN(k) && IN((k) + 1)) xcd_barrier(bar); } while (0)
    const float* ada = (const float*)(ws + WS_ADA);

    if (IN(0)) { phase_prologue(args, lds); } SEAM(0);
    if (IN(1)) { phase_modnorm(args.x, args.norm1, ada, args.b_ada, 0, (bf16*)(ws + WS_H1)); } SEAM(1);
    if (IN(2)) {
        pg8::Gemm g{(const bf16*)(ws + WS_H1), (const bf16*)(ws + WS_WIN), T, NIN, DM, DM, DM, 30, 0}; pg8::StaticOrder S; S.init(T, NIN, G, (int)blockIdx.x);
        EpiProj E{(bf16*)(ws + WS_P), (bf16*)(ws + WS_I), (bf16*)(ws + WS_GA), (bf16*)(ws + WS_GG), (unsigned*)(ws + WS_Q), (const float*)(ws + WS_LB)};
        pg8::gemm_phase<EpiProj, true>(lds, g, S, E);
    } SEAM(2);
    if (IN(3)) { phase_pool((const bf16*)(ws + WS_P), (bf16*)(ws + WS_POOLED)); } SEAM(3);
    if (IN(4)) {
        pg8::Gemm g{(const bf16*)(ws + WS_POOLED), (const bf16*)(ws + WS_POOLW), T, DM, 256, 1024, 256, 1, 256}; pg8::StaticOrder S; S.init(T, DM, G, (int)blockIdx.x);
        EpiPool E{(bf16*)(ws + WS_YA), args.pool_scale};
        pg8::gemm_phase<EpiPool, true>(lds, g, S, E);
    } SEAM(4);
    if (IN(5)) { phase_hgrn_fast(args, lds); } SEAM(5);
    if (IN(6)) {
        pg8::Gemm g{(const bf16*)(ws + WS_MERGED), (const bf16*)(ws + WS_WOUT), T, DM, DM, DM, DM, 30, 0}; pg8::StaticOrder S; S.init(T, DM, G, (int)blockIdx.x);
        EpiRes E{args.x, args.out, ada, args.b_ada};
        pg8::gemm_phase<EpiRes, true>(lds, g, S, E);
    } SEAM(6);
    if (IN(7)) { phase_modnorm(args.out, args.norm2, ada, args.b_ada, 3 * DM, (bf16*)(ws + WS_H2)); } SEAM(7);
    if (IN(8)) {
        pg8::Gemm g{(const bf16*)(ws + WS_H2), (const bf16*)(ws + WS_WQ), T, DM, DM, DM, DM, 30, 0}; pg8::StaticOrder S; S.init(T, DM, G, (int)blockIdx.x);
        EpiBf16 E{(bf16*)(ws + WS_QP), DM};
        pg8::gemm_phase<EpiBf16, true>(lds, g, S, E);
    } SEAM(8);
    if (IN(9)) { phase_route(args, lds); } SEAM(9);
    if (IN(10)) { phase_peer(args, lds); }
#undef IN
#undef SEAM
}

extern "C" void kernel_launch(void* const* d_in, const int* in_sizes, int n_in, void* d_out, int out_size, void* d_ws, size_t ws_size, hipStream_t stream) {
    static int grid = 0;
    if (grid == 0) {
        if (n_in != 17 || in_sizes[0] != T * DM || out_size != T * DM || ws_size < WS_END) {
            fprintf(stderr, "kernel_launch: unexpected shapes (n_in %d, in0 %d, out %d, ws %zu < %zu); nothing launched\n", n_in, n_in > 0 ? in_sizes[0] : -1, out_size, ws_size, (size_t)WS_END); grid = -1; return; }
        int dev = 0, cus = 0, per_cu = 0;
        if (hipGetDevice(&dev) != hipSuccess || hipDeviceGetAttribute(&cus, hipDeviceAttributeMultiprocessorCount, dev) != hipSuccess) { fprintf(stderr, "kernel_launch: device query failed\n"); grid = -1; return; }
        if (hipFuncSetAttribute((const void*)fwd_kernel, hipFuncAttributeMaxDynamicSharedMemorySize, LDS_BYTES) != hipSuccess) { fprintf(stderr, "kernel_launch: hipFuncSetAttribute failed\n"); grid = -1; return; }
        if (hipOccupancyMaxActiveBlocksPerMultiprocessor(&per_cu, (const void*)fwd_kernel, NTHR, LDS_BYTES) != hipSuccess || per_cu < 1) { fprintf(stderr, "kernel_launch: occupancy query reports %d blocks per CU\n", per_cu); }
        (void)hipGetLastError();
        grid = cus;
    }
    if (grid < 0) return;
    (void)hipMemsetAsync((char*)d_ws + WS_CTL, 0, CTL_ZERO_BYTES, stream);
    Args a{};
    a.x = (const float*)d_in[0]; a.c = (const float*)d_in[1]; a.w_ada = (const float*)d_in[2]; a.b_ada = (const float*)d_in[3]; a.norm1 = (const float*)d_in[4];
    a.w_in = (const float*)d_in[5]; a.pool_w = (const float*)d_in[6]; a.pool_scale = (const float*)d_in[7]; a.lb_logits = (const float*)d_in[8]; a.hg_norm = (const float*)d_in[9];
    a.w_out = (const float*)d_in[10]; a.norm2 = (const float*)d_in[11]; a.peer_wq = (const float*)d_in[12]; a.peer_keys = (const float*)d_in[13]; a.peer_u = (const float*)d_in[14];
    a.peer_v = (const float*)d_in[15]; a.final_norm = (const float*)d_in[16];
    a.out = (float*)d_out; a.ws = (unsigned char*)d_ws;
    if (N_LAUNCHES == 1) {
        a.ph_lo = 0; a.ph_hi = N_PHASES; a.li = 0;
        hipLaunchKernelGGL(fwd_kernel, dim3(grid), dim3(NTHR), LDS_BYTES, stream, a);
    } else {
        for (int li = 0; li < N_PHASES; ++li) { a.ph_lo = li; a.ph_hi = li + 1; a.li = li; hipLaunchKernelGGL(fwd_kernel, dim3(grid), dim3(NTHR), LDS_BYTES, stream, a); }
    }
    const hipError_t le = hipPeekAtLastError();
    if (le != hipSuccess) fprintf(stderr, "kernel_launch: launch failed: %s\n", hipGetErrorName(le));
}
```
